# Optimizing an MI355X kernel written in HIP

```python
import math
import jax, jax.numpy as jnp
from jax import lax
import numpy as np

D_MODEL = 1024
BATCH = 16
SEQ = 4096
DEPTH = 1

N_META = 16
E_CONV = D_MODEL
K_CONV_A = 3
E_LRU = D_MODEL
LRU_HEAD_DIM = 256
N_LRU_HEADS = E_LRU // LRU_HEAD_DIM
K_CONV_B = 4
C_LRU = 8.0
RMS_EPS = 1e-6
N_IN = 4 * E_CONV + 2 * E_LRU + 2 * D_MODEL

kernel_name = "hybrid_shortconv_rglru_gated_merge"


def rms_norm(x, g):
    xf = x.astype(jnp.float32)
    y = xf * lax.rsqrt(jnp.mean(xf * xf, axis=-1, keepdims=True) + RMS_EPS)
    return (y * g.astype(jnp.float32)).astype(x.dtype)


def causal_dwconv(x, w):
    k_len = w.shape[0]
    s = x.shape[1]
    xp = jnp.pad(x, ((0, 0), (k_len - 1, 0), (0, 0)))
    y = xp[:, 0:s] * w[0]
    for k in range(1, k_len):
        y = y + xp[:, k:k + s] * w[k]
    return y


def rg_lru(x, w_a, b_a, w_i, b_i, lam):
    bn, s, e = x.shape
    xf = x.astype(jnp.float32)
    xh = xf.reshape(bn, s, N_LRU_HEADS, LRU_HEAD_DIM)
    r = jax.nn.sigmoid(jnp.einsum('bshi,hij->bshj', xh, w_a.astype(jnp.float32)) + b_a.astype(jnp.float32)).reshape(bn, s, e)
    i = jax.nn.sigmoid(jnp.einsum('bshi,hij->bshj', xh, w_i.astype(jnp.float32)) + b_i.astype(jnp.float32)).reshape(bn, s, e)
    log_a = -C_LRU * r * jax.nn.softplus(-lam.astype(jnp.float32))
    a = jnp.exp(log_a)
    mult = jnp.sqrt(-jnp.expm1(2.0 * log_a))
    is_first = (jnp.arange(s) == 0)[None, :, None]
    mult = jnp.where(is_first, 1.0, mult)
    u = xf * i * mult

    def combine(left, right):
        a_l, b_l = left
        a_r, b_r = right
        return a_l * a_r, a_r * b_l + b_r

    _, h = lax.associative_scan(combine, (a, u), axis=1)
    return h.astype(x.dtype)


def setup_inputs(seed: int = 0) -> dict:
    key = jax.random.key(seed)
    ks = jax.random.split(key, 18)
    f32 = jnp.float32
    nrm = lambda k, shape, scale: jax.random.normal(k, shape, f32) * scale
    x = jax.random.normal(ks[0], (BATCH, SEQ, D_MODEL), f32)
    meta = nrm(ks[1], (N_META, D_MODEL), 1.0)
    norm_g = 1.0 + nrm(ks[2], (DEPTH, D_MODEL), 0.02)
    w_in = nrm(ks[3], (DEPTH, D_MODEL, N_IN), D_MODEL ** -0.5)
    b_gate = nrm(ks[4], (DEPTH, 2 * D_MODEL), 0.02)
    conv_a_w = nrm(ks[5], (DEPTH, K_CONV_A, E_CONV), K_CONV_A ** -0.5)
    w_proj_a = nrm(ks[6], (DEPTH, E_CONV, D_MODEL), E_CONV ** -0.5)
    conv_b_w = nrm(ks[7], (DEPTH, K_CONV_B, E_LRU), K_CONV_B ** -0.5)
    conv_b_b = nrm(ks[8], (DEPTH, E_LRU), 0.02)
    w_rg_a = nrm(ks[9], (DEPTH, N_LRU_HEADS, LRU_HEAD_DIM, LRU_HEAD_DIM), LRU_HEAD_DIM ** -0.5)
    b_rg_a = nrm(ks[10], (DEPTH, N_LRU_HEADS, LRU_HEAD_DIM), 0.02)
    w_rg_i = nrm(ks[11], (DEPTH, N_LRU_HEADS, LRU_HEAD_DIM, LRU_HEAD_DIM), LRU_HEAD_DIM ** -0.5)
    b_rg_i = nrm(ks[12], (DEPTH, N_LRU_HEADS, LRU_HEAD_DIM), 0.02)
    a_c = jax.random.uniform(ks[13], (DEPTH, E_LRU), f32, 0.9, 0.999)
    s_base = a_c ** (1.0 / C_LRU)
    lru_param = jnp.log(s_base) - jnp.log1p(-s_base)
    w_proj_b = nrm(ks[14], (DEPTH, E_LRU, D_MODEL), E_LRU ** -0.5)
    w_out = nrm(ks[15], (DEPTH, D_MODEL, D_MODEL), D_MODEL ** -0.5)
    final_norm_g = 1.0 + nrm(ks[16], (D_MODEL,), 0.02)
    return {"x": x, "meta": meta, "norm_g": norm_g, "w_in": w_in, "b_gate": b_gate,
            "conv_a_w": conv_a_w, "w_proj_a": w_proj_a, "conv_b_w": conv_b_w, "conv_b_b": conv_b_b,
            "w_rg_a": w_rg_a, "b_rg_a": b_rg_a, "w_rg_i": w_rg_i, "b_rg_i": b_rg_i,
            "lru_param": lru_param, "w_proj_b": w_proj_b, "w_out": w_out, "final_norm_g": final_norm_g}


def reference(x, meta, norm_g, w_in, b_gate, conv_a_w, w_proj_a, conv_b_w, conv_b_b,
              w_rg_a, b_rg_a, w_rg_i, b_rg_i, lru_param, w_proj_b, w_out, final_norm_g):
    bn = x.shape[0]
    meta_b = jnp.broadcast_to(meta[None].astype(x.dtype), (bn, N_META, D_MODEL))
    h = jnp.concatenate([meta_b, x], axis=1)
    split_idx = [E_CONV, 2 * E_CONV, 3 * E_CONV, 4 * E_CONV,
                 4 * E_CONV + E_LRU, 4 * E_CONV + 2 * E_LRU, 4 * E_CONV + 2 * E_LRU + D_MODEL]
    for l in range(DEPTH):
        xn = rms_norm(h, norm_g[l])
        proj = xn @ w_in[l]
        b_a, c_a, h_a, z_a, x_b, z_b, g_a, g_b = jnp.split(proj, split_idx, axis=-1)
        y_a = b_a * causal_dwconv(c_a * h_a, conv_a_w[l])
        y_a = (y_a * jax.nn.silu(z_a)) @ w_proj_a[l]
        x_c = causal_dwconv(x_b, conv_b_w[l]) + conv_b_b[l]
        y_b = rg_lru(x_c, w_rg_a[l], b_rg_a[l], w_rg_i[l], b_rg_i[l], lru_param[l])
        y_b = (y_b * jax.nn.silu(z_b)) @ w_proj_b[l]
        gate_a = jax.nn.sigmoid(g_a + b_gate[l, :D_MODEL])
        gate_b = jax.nn.sigmoid(g_b + b_gate[l, D_MODEL:])
        merged = gate_a * y_a + gate_b * y_b
        h = h + merged @ w_out[l]
    out = rms_norm(h, final_norm_g)
    return out[:, N_META:]
```

```cpp
#include <hip/hip_runtime.h>
#include <cstdio>
#include <cstdint>

#ifndef MK_N_LAUNCHES
#define MK_N_LAUNCHES 7
#endif

#define LAS __attribute__((address_space(3)))
#define GAS __attribute__((address_space(1)))
typedef unsigned short bf16_t;
typedef short bf16x8 __attribute__((ext_vector_type(8)));
typedef float f32x4 __attribute__((ext_vector_type(4)));
typedef float f32x16 __attribute__((ext_vector_type(16)));
typedef unsigned u32x4 __attribute__((ext_vector_type(4)));
typedef unsigned u32x2 __attribute__((ext_vector_type(2)));

constexpr int D = 1024, NBATCH = 16, SEQ = 4096, NMETA = 16, NIN = 8192;
constexpr int MR = NBATCH * SEQ;
constexpr int MP = MR + 256;
constexpr float RMS_EPS = 1e-6f;
constexpr float L2E = 1.4426950408889634f;

constexpr size_t MiB = 1u << 20;
constexpr size_t WS_CTL = 0, CTL_ZERO_BYTES = 1 * MiB;
constexpr size_t WS_RS = 512 * 1024;
constexpr size_t WS_WIN = 2 * MiB;
constexpr size_t WS_WAB = 18 * MiB;
constexpr size_t WS_WOUT = 22 * MiB;
constexpr size_t WS_WGA = 24 * MiB;
constexpr size_t WS_WGI = WS_WGA + 512 * 1024;
constexpr size_t ACT = 129 * MiB;
constexpr size_t WS_XN = 32 * MiB;
constexpr size_t WS_PB = WS_XN + ACT;
constexpr size_t WS_XB = WS_PB + ACT;
constexpr size_t WS_UV = WS_XB + ACT;
constexpr size_t WS_GR = WS_UV + 2 * ACT;
constexpr size_t WS_GB = WS_GR + ACT;
constexpr size_t WS_END = WS_GB + ACT;
static_assert((size_t)MP * 1024 * 2 <= ACT, "activation slot");
static_assert(WS_END <= 1024 * MiB, "workspace");

namespace pg8 {
constexpr int BM = 256, BK = 64, HALF = 128, HTB = HALF * BK * 2, STAGE_BYTES = 8 * HTB, NXCD = 8, WGM = 8;

__host__ __device__ __forceinline__ int lds_byte(int r, int c) { const int st = (r >> 4) * 2 + (c >> 5), rr = r & 15, cc = c & 31, ob = rr * 64 + cc * 2; return st * 1024 + (ob ^ (((ob >> 9) & 1) << 5)); }
__host__ __device__ __forceinline__ void stage_rc(int b, int& R, int& C) { const int st = b / 1024, sb = b % 1024, swz = sb ^ (((sb >> 9) & 1) << 5); R = (st >> 1) * 16 + swz / 64; C = (st & 1) * 32 + (swz % 64) / 2; }
__host__ __device__ __forceinline__ int perm32(int rho) { const int n = rho >> 4, i = rho & 15; return 8 * (i >> 2) + 4 * n + (i & 3); }

struct Unit { int pm, pn; };
struct Gemm { const bf16_t* A; const bf16_t* Bt; int lda, ldb, K; };

struct StaticOrder {
    int nM, nN, nwg, G, c;
    __host__ __device__ void init(int nM_, int nN_, int G_, int c_) { nM = nM_; nN = nN_; nwg = nM * nN; G = G_; c = c_; }
    __host__ __device__ bool next(int i, Unit& u) const {
        const long L = (long)i * G + c; if (L >= nwg) return false;
        int wgid = (int)L; { const int q = nwg / NXCD, r = nwg % NXCD, xcd = wgid % NXCD, off = wgid / NXCD; wgid = (xcd < r ? xcd * (q + 1) : r * (q + 1) + (xcd - r) * q) + off; }
        const int nig = WGM * nN, gid = wgid / nig, fm = gid * WGM, gsz = (nM - fm) < WGM ? (nM - fm) : WGM;
        u.pm = fm + ((wgid % nig) % gsz); u.pn = (wgid % nig) / gsz; return true;
    }
    __device__ __forceinline__ void a_ready(const Unit&) const {}
    __device__ __forceinline__ void done(const Unit&) const {}
};

__device__ __forceinline__ unsigned cvt_pk_bf16(float lo, float hi) { unsigned r; asm volatile("v_cvt_pk_bf16_f32 %0, %1, %2" : "=v"(r) : "v"(lo), "v"(hi)); return r; }

template <class Epi, class Sched, bool ALIGN_EPI = false, bool SP2 = false>
__device__ __forceinline__ void gemm_phase(LAS unsigned char* lds, const Gemm g, const Sched& S, const Epi& E) {
    const int tid = threadIdx.x, wid = __builtin_amdgcn_readfirstlane(tid >> 6), lane = tid & 63, wr = wid >> 2, wc = wid & 3, fr = lane & 15, fq = lane >> 4;
    const int K = g.K, nt = K / BK;
    unsigned voffA[2], voffB[2];
#pragma unroll
    for (int i = 0; i < 2; ++i) { int R, C; stage_rc(tid * 16 + i * 8192, R, C); const int Rb = Epi::PERM ? ((R & ~31) + perm32(R & 31)) : R;
        voffA[i] = (unsigned)(R * g.lda + C) * 2u; voffB[i] = (unsigned)(Rb * g.ldb + C) * 2u; }
    const size_t kstep = (size_t)(BK * 2);
    const size_t hstepA = (size_t)HALF * g.lda * 2, hstepB = (size_t)HALF * g.ldb * 2;
    const size_t tstepA = 2 * hstepA, tstepB = 2 * hstepB;
    const unsigned ldsw = (unsigned)wid * 1024u;
    const int aoff = lds_byte(wr * 64 + fr, fq * 8), boff = lds_byte(wc * 32 + fr, fq * 8);
#define PG8_SA(b, h) (((b) * 2 + (h)) * HTB)
#define PG8_SB(b, h) ((4 + (b) * 2 + (h)) * HTB)
#define PG8_STAGE(bufoff, gbase, voff) do { _Pragma("unroll") for (int _i = 0; _i < 2; ++_i) \
        __builtin_amdgcn_global_load_lds((const unsigned*)((const char*)(gbase) + (voff)[_i]), (LAS unsigned*)(lds + (bufoff) + ldsw + _i * 8192), 16, 0, 0); } while (0)
#define PG8_LDA(dst, b, h) do { _Pragma("unroll") for (int m = 0; m < 4; ++m) _Pragma("unroll") for (int k = 0; k < 2; ++k) dst[m][k] = *(const LAS bf16x8*)(lds + PG8_SA(b, h) + aoff + m * 2048 + k * 1024); } while (0)
#define PG8_LDB(dst, b, h) do { _Pragma("unroll") for (int n = 0; n < 2; ++n) _Pragma("unroll") for (int k = 0; k < 2; ++k) dst[n][k] = *(const LAS bf16x8*)(lds + PG8_SB(b, h) + boff + n * 2048 + k * 1024); } while (0)
#define PG8_MMA(ai, bj, At, Bt) do { __builtin_amdgcn_s_setprio(1); _Pragma("unroll") for (int m = 0; m < 4; ++m) _Pragma("unroll") for (int n = 0; n < 2; ++n) _Pragma("unroll") for (int k = 0; k < 2; ++k) \
        acc[ai][bj][m][n] = __builtin_amdgcn_mfma_f32_16x16x32_bf16(Bt[n][k], At[m][k], acc[ai][bj][m][n], 0, 0, 0); __builtin_amdgcn_s_setprio(0); } while (0)
#define PG8_WAIT_V(n) asm volatile("s_waitcnt vmcnt(" #n ")" ::: "memory")
#define PG8_WAIT_L(n) asm volatile("s_waitcnt lgkmcnt(" #n ")" ::: "memory")
#define PG8_BAR __builtin_amdgcn_s_barrier()
#define PG8_SCHED __builtin_amdgcn_sched_barrier(0)
    Unit cur, nxt; int ui = 0;
    if (!S.next(0, cur)) return;
    f32x4 acc[2][2][4][2];
#pragma unroll
    for (int a = 0; a < 2; ++a)
#pragma unroll
        for (int b = 0; b < 2; ++b)
#pragma unroll
            for (int m = 0; m < 4; ++m)
#pragma unroll
                for (int n = 0; n < 2; ++n) acc[a][b][m][n] = (f32x4){0.f, 0.f, 0.f, 0.f};
    bf16x8 At[4][2], B0[2][2], B1[2][2];
    const char* cA = (const char*)g.A + (size_t)cur.pm * tstepA; const char* cB = (const char*)g.Bt + (size_t)cur.pn * tstepB;
    S.a_ready(cur);
    if constexpr (SP2) {
        PG8_STAGE(PG8_SB(0, 0), cB, voffB); PG8_STAGE(PG8_SB(0, 1), cB + hstepB, voffB); PG8_STAGE(PG8_SA(0, 0), cA, voffA); PG8_STAGE(PG8_SA(0, 1), cA + hstepA, voffA);
        if (wr == 1) PG8_BAR;
        PG8_WAIT_V(2); PG8_BAR;
        PG8_STAGE(PG8_SB(1, 0), cB + kstep, voffB); PG8_STAGE(PG8_SA(1, 0), cA + kstep, voffA); PG8_STAGE(PG8_SB(1, 1), cB + hstepB + kstep, voffB);
        PG8_WAIT_V(6); PG8_BAR;
    } else {
        PG8_STAGE(PG8_SB(0, 0), cB, voffB); PG8_STAGE(PG8_SA(0, 0), cA, voffA); PG8_STAGE(PG8_SB(0, 1), cB + hstepB, voffB); PG8_STAGE(PG8_SA(0, 1), cA + hstepA, voffA);
        if (wr == 1) PG8_BAR;
        PG8_WAIT_V(4); PG8_BAR;
        PG8_STAGE(PG8_SB(1, 0), cB + kstep, voffB); PG8_STAGE(PG8_SA(1, 0), cA + kstep, voffA); PG8_STAGE(PG8_SB(1, 1), cB + hstepB + kstep, voffB);
        PG8_WAIT_V(6); PG8_BAR;
    }
    for (;;) {
        const bool has_next = S.next(ui + 1, nxt);
        const char* nA = has_next ? (const char*)g.A + (size_t)nxt.pm * tstepA : cA; const char* nB = has_next ? (const char*)g.Bt + (size_t)nxt.pn * tstepB : cB;
        for (int t = 0; t < nt; t += 2) {
            const bool last = (t == nt - 2);
            const char* a1 = cA + (size_t)(t + 1) * kstep;
            const char* a2 = last ? nA : cA + (size_t)(t + 2) * kstep; const char* b2 = last ? nB : cB + (size_t)(t + 2) * kstep;
            const char* a3 = a2 + kstep; const char* b3 = b2 + kstep;
            if constexpr (Epi::HAS_MID) { if (t == Epi::MID_T) E.mid(acc, cur, wr, wc, fr, fq); }
            if (last && has_next) S.a_ready(nxt);
            if constexpr (SP2) {
            PG8_LDB(B0, 0, 0); PG8_LDB(B1, 0, 1); PG8_SCHED; PG8_LDA(At, 0, 0); PG8_STAGE(PG8_SA(1, 1), a1 + hstepA, voffA);
            PG8_WAIT_V(8); PG8_WAIT_L(0); PG8_BAR; PG8_MMA(0, 0, At, B0); PG8_MMA(0, 1, At, B1); PG8_BAR; PG8_SCHED;
            PG8_LDA(At, 0, 1); PG8_STAGE(PG8_SB(0, 0), b2, voffB); PG8_STAGE(PG8_SB(0, 1), b2 + hstepB, voffB); PG8_STAGE(PG8_SA(0, 0), a2, voffA);
            PG8_WAIT_V(8); PG8_WAIT_L(0); PG8_BAR; PG8_MMA(1, 0, At, B0); PG8_MMA(1, 1, At, B1); PG8_BAR; PG8_SCHED;
            PG8_LDB(B0, 1, 0); PG8_LDB(B1, 1, 1); PG8_SCHED; PG8_LDA(At, 1, 0); PG8_STAGE(PG8_SA(0, 1), a2 + hstepA, voffA);
            PG8_WAIT_V(8); PG8_WAIT_L(0); PG8_BAR; PG8_MMA(0, 0, At, B0); PG8_MMA(0, 1, At, B1); PG8_BAR; PG8_SCHED;
            PG8_LDA(At, 1, 1); PG8_STAGE(PG8_SB(1, 0), b3, voffB); PG8_STAGE(PG8_SB(1, 1), b3 + hstepB, voffB); PG8_STAGE(PG8_SA(1, 0), a3, voffA);
            PG8_WAIT_V(8); PG8_WAIT_L(0); PG8_BAR; PG8_MMA(1, 0, At, B0); PG8_MMA(1, 1, At, B1); PG8_BAR; PG8_SCHED;
            } else {
            PG8_LDB(B0, 0, 0); PG8_SCHED; PG8_LDA(At, 0, 0); PG8_STAGE(PG8_SA(1, 1), a1 + hstepA, voffA);
            PG8_WAIT_L(8); PG8_BAR; PG8_WAIT_L(0); PG8_MMA(0, 0, At, B0); PG8_BAR; PG8_SCHED;
            PG8_LDB(B1, 0, 1); PG8_STAGE(PG8_SB(0, 0), b2, voffB);
            PG8_BAR; PG8_WAIT_L(0); PG8_MMA(0, 1, At, B1); PG8_BAR;
            PG8_LDA(At, 0, 1); PG8_STAGE(PG8_SA(0, 0), a2, voffA);
            PG8_BAR; PG8_WAIT_L(0); PG8_MMA(1, 0, At, B0); PG8_BAR; PG8_SCHED;
            PG8_STAGE(PG8_SB(0, 1), b2 + hstepB, voffB);
            PG8_WAIT_V(6); PG8_BAR; PG8_MMA(1, 1, At, B1); PG8_BAR;
            PG8_LDB(B0, 1, 0); PG8_SCHED; PG8_LDA(At, 1, 0); PG8_STAGE(PG8_SA(0, 1), a2 + hstepA, voffA);
            PG8_WAIT_L(8); PG8_BAR; PG8_WAIT_L(0); PG8_MMA(0, 0, At, B0); PG8_BAR; PG8_SCHED;
            PG8_LDB(B1, 1, 1); PG8_STAGE(PG8_SB(1, 0), b3, voffB);
            PG8_BAR; PG8_WAIT_L(0); PG8_MMA(0, 1, At, B1); PG8_BAR;
            PG8_LDA(At, 1, 1); PG8_STAGE(PG8_SA(1, 0), a3, voffA);
            PG8_BAR; PG8_WAIT_L(0); PG8_MMA(1, 0, At, B0); PG8_BAR; PG8_SCHED;
            PG8_STAGE(PG8_SB(1, 1), b3 + hstepB, voffB);
            PG8_WAIT_V(6); PG8_BAR; PG8_MMA(1, 1, At, B1); PG8_BAR;
            }
        }
        if constexpr (ALIGN_EPI) { if (wr == 0) PG8_BAR; }
        E(acc, cur, wr, wc, fr, fq); S.done(cur);
        if (!has_next) break;
#pragma unroll
        for (int a = 0; a < 2; ++a)
#pragma unroll
            for (int b = 0; b < 2; ++b)
#pragma unroll
                for (int m = 0; m < 4; ++m)
#pragma unroll
                    for (int n = 0; n < 2; ++n) acc[a][b][m][n] = (f32x4){0.f, 0.f, 0.f, 0.f};
        cur = nxt; cA = nA; cB = nB; ++ui;
        if constexpr (ALIGN_EPI) { if (wr == 1) PG8_BAR; }
    }
    PG8_WAIT_V(0);
    if constexpr (!ALIGN_EPI) { if (wr == 0) PG8_BAR; }
    PG8_BAR;
#undef PG8_SA
#undef PG8_SB
#undef PG8_STAGE
#undef PG8_LDA
#undef PG8_LDB
#undef PG8_MMA
#undef PG8_WAIT_V
#undef PG8_WAIT_L
#undef PG8_BAR
#undef PG8_SCHED
}
}

__device__ __forceinline__ float fsigmoid(float x) { return __builtin_amdgcn_rcpf(1.0f + __builtin_amdgcn_exp2f(-L2E * x)); }
__device__ __forceinline__ float bf_lo(unsigned w) { return __builtin_bit_cast(float, w << 16); }
__device__ __forceinline__ float bf_hi(unsigned w) { return __builtin_bit_cast(float, w & 0xffff0000u); }
__device__ __forceinline__ unsigned f2bf(float f) { unsigned u = __builtin_bit_cast(unsigned, f); return (u + 0x7fffu + ((u >> 16) & 1u)) >> 16; }
__device__ __forceinline__ unsigned pk2(float lo, float hi) { return f2bf(lo) | (f2bf(hi) << 16); }
using pg8::cvt_pk_bf16;

struct EpiP1 {
    static constexpr bool PERM = false, HAS_MID = false; static constexpr int MID_T = -2;
    bf16_t* PB; bf16_t* UV; bf16_t* XB; bf16_t* GR; bf16_t* GB; const float* bgate;
    __device__ __forceinline__ void mid(f32x4 (&)[2][2][4][2], const pg8::Unit&, int, int, int, int) const {}
    __device__ __forceinline__ void operator()(const f32x4 (&acc)[2][2][4][2], const pg8::Unit& u, int wr, int wc, int fr, int fq) const {
        int pm_ = u.pm; asm volatile("" : "+s"(pm_));
        const int type = u.pn & 1, ch = (u.pn >> 1) * 64 + wc * 16 + fq * 4;
        const int row0 = pm_ * 256 + wr * 64 + fr;
        if (type == 0) {
#pragma unroll
            for (int ai = 0; ai < 2; ++ai)
#pragma unroll
                for (int m = 0; m < 4; ++m) {
                    const size_t row = (size_t)(row0 + ai * 128 + m * 16);
                    const f32x4 vb = acc[ai][0][m][0], vc = acc[ai][0][m][1], vh = acc[ai][1][m][0], vz = acc[ai][1][m][1];
                    f32x4 p = vc * vh, q;
#pragma unroll
                    for (int j = 0; j < 4; ++j) q[j] = vb[j] * vz[j] * fsigmoid(vz[j]);
                    u32x2 wp, wq; wp.x = cvt_pk_bf16(p[0], p[1]); wp.y = cvt_pk_bf16(p[2], p[3]); wq.x = cvt_pk_bf16(q[0], q[1]); wq.y = cvt_pk_bf16(q[2], q[3]);
                    *(u32x2*)(PB + row * 1024 + ch) = wp;
                    *(u32x2*)(UV + row * 2048 + ch) = wq;
                }
        } else {
            const f32x4 bga = *(const f32x4*)(bgate + ch), bgb = *(const f32x4*)(bgate + 1024 + ch);
#pragma unroll
            for (int ai = 0; ai < 2; ++ai)
#pragma unroll
                for (int m = 0; m < 4; ++m) {
                    const size_t row = (size_t)(row0 + ai * 128 + m * 16);
                    const f32x4 vx = acc[ai][0][m][0], vz = acc[ai][0][m][1], va = acc[ai][1][m][0], vb = acc[ai][1][m][1];
                    f32x4 sz, gr, gb;
#pragma unroll
                    for (int j = 0; j < 4; ++j) {
                        sz[j] = vz[j] * fsigmoid(vz[j]);
                        const float ea = __builtin_amdgcn_exp2f(-L2E * (va[j] + bga[j]));
                        const float eb = __builtin_amdgcn_exp2f(-L2E * fmaxf(vb[j] + bgb[j], -60.f));
                        const float ga = __builtin_amdgcn_rcpf(1.0f + ea);
                        gb[j] = __builtin_amdgcn_rcpf(1.0f + eb);
                        gr[j] = ga * (1.0f + eb);
                    }
                    u32x2 w0, w1, w2, w3;
                    w0.x = cvt_pk_bf16(vx[0], vx[1]); w0.y = cvt_pk_bf16(vx[2], vx[3]);
                    w1.x = cvt_pk_bf16(sz[0], sz[1]); w1.y = cvt_pk_bf16(sz[2], sz[3]);
                    w2.x = cvt_pk_bf16(gr[0], gr[1]); w2.y = cvt_pk_bf16(gr[2], gr[3]);
                    w3.x = cvt_pk_bf16(gb[0], gb[1]); w3.y = cvt_pk_bf16(gb[2], gb[3]);
                    *(u32x2*)(XB + row * 1024 + ch) = w0;
                    *(u32x2*)(UV + row * 2048 + 1024 + ch) = w1;
                    *(u32x2*)(GR + row * 1024 + ch) = w2;
                    *(u32x2*)(GB + row * 1024 + ch) = w3;
                }
        }
    }
};

struct EpiP3 {
    static constexpr bool PERM = true, HAS_MID = true; static constexpr int MID_T = 16;
    const bf16_t* GR; const bf16_t* GB; bf16_t* MG;
    __device__ __forceinline__ void mid(f32x4 (&acc)[2][2][4][2], const pg8::Unit& u, int wr, int wc, int fr, int fq) const {
        int pm_ = u.pm; asm volatile("" : "+s"(pm_));
        const int row0 = pm_ * 256 + wr * 64 + fr, col0 = u.pn * 256 + wc * 32 + 8 * fq;
#pragma unroll
        for (int ai = 0; ai < 2; ++ai)
#pragma unroll
            for (int m = 0; m < 4; ++m) { const bf16_t* rp = GR + (size_t)(row0 + ai * 128 + m * 16) * 1024 + col0;
#pragma unroll
                for (int bj = 0; bj < 2; ++bj) { const u32x4 w = *(const u32x4*)(rp + bj * 128);
                    acc[ai][bj][m][0] *= (f32x4){bf_lo(w.x), bf_hi(w.x), bf_lo(w.y), bf_hi(w.y)};
                    acc[ai][bj][m][1] *= (f32x4){bf_lo(w.z), bf_hi(w.z), bf_lo(w.w), bf_hi(w.w)}; }
                asm volatile("" ::: "memory"); }
    }
    __device__ __forceinline__ void operator()(const f32x4 (&acc)[2][2][4][2], const pg8::Unit& u, int wr, int wc, int fr, int fq) const {
        int pm_ = u.pm; asm volatile("" : "+s"(pm_));
        const int row0 = pm_ * 256 + wr * 64 + fr, col0 = u.pn * 256 + wc * 32 + 8 * fq;
#pragma unroll
        for (int ai = 0; ai < 2; ++ai)
#pragma unroll
            for (int m = 0; m < 4; ++m) { const size_t off = (size_t)(row0 + ai * 128 + m * 16) * 1024 + col0;
#pragma unroll
                for (int bj = 0; bj < 2; ++bj) { const u32x4 w = *(const u32x4*)(GB + off + bj * 128);
                    const f32x4 v0 = acc[ai][bj][m][0] * (f32x4){bf_lo(w.x), bf_hi(w.x), bf_lo(w.y), bf_hi(w.y)};
                    const f32x4 v1 = acc[ai][bj][m][1] * (f32x4){bf_lo(w.z), bf_hi(w.z), bf_lo(w.w), bf_hi(w.w)};
                    u32x4 o; o.x = cvt_pk_bf16(v0[0], v0[1]); o.y = cvt_pk_bf16(v0[2], v0[3]); o.z = cvt_pk_bf16(v1[0], v1[1]); o.w = cvt_pk_bf16(v1[2], v1[3]);
                    *(u32x4*)(MG + off + bj * 128) = o; }
                asm volatile("" ::: "memory"); }
    }
};

struct EpiP4 {
    static constexpr bool PERM = true, HAS_MID = false; static constexpr int MID_T = -2;
    const float* X; float* OUT; float* RS;
    __device__ __forceinline__ void mid(f32x4 (&)[2][2][4][2], const pg8::Unit&, int, int, int, int) const {}
    __device__ __forceinline__ void operator()(const f32x4 (&acc)[2][2][4][2], const pg8::Unit& u, int wr, int wc, int fr, int fq) const {
        int pm_ = u.pm; asm volatile("" : "+s"(pm_));
        const int row0 = pm_ * 256 + wr * 64 + fr, col0 = u.pn * 256 + wc * 32 + 8 * fq;
#pragma unroll
        for (int ai = 0; ai < 2; ++ai)
#pragma unroll
            for (int m = 0; m < 4; ++m) { const int row = row0 + ai * 128 + m * 16; const size_t off = (size_t)row * 1024 + col0; float s = 0.f;
#pragma unroll
                for (int bj = 0; bj < 2; ++bj) {
                    const f32x4 x0 = *(const f32x4*)(X + off + bj * 128), x1 = *(const f32x4*)(X + off + bj * 128 + 4);
                    const f32x4 h0 = x0 + acc[ai][bj][m][0], h1 = x1 + acc[ai][bj][m][1];
                    s += (h0[0] * h0[0] + h0[1] * h0[1]) + (h0[2] * h0[2] + h0[3] * h0[3]) + (h1[0] * h1[0] + h1[1] * h1[1]) + (h1[2] * h1[2] + h1[3] * h1[3]);
                    *(f32x4*)(OUT + off + bj * 128) = h0; *(f32x4*)(OUT + off + bj * 128 + 4) = h1; }
                s += __shfl_xor(s, 16); s += __shfl_xor(s, 32);
                if (fq == 0) atomicAdd(RS + row, s);
                asm volatile("" ::: "memory"); }
    }
};

constexpr int RING_OFF = 0, RING_BYTES = 131072;
constexpr int LDSCTL_OFF = RING_BYTES, MISC_OFF = LDSCTL_OFF + 320;
constexpr int LDS_BYTES = 147456;
constexpr int NWAVES = 8;

typedef GAS unsigned gu32;
#define RLX_AGENT __ATOMIC_RELAXED, __HIP_MEMORY_SCOPE_AGENT
#define LDS_WAIT() asm volatile("s_waitcnt lgkmcnt(0)" ::: "memory")
#define VM_WAIT() asm volatile("s_waitcnt vmcnt(0)" ::: "memory")

#define XB_TMO      128
#define XB_XCNT(j)  (256  + 64 * (j))
#define XB_XSUB(j)  (1280 + 64 * (j))
#define XB_XGEN(j)  (2304 + 64 * (j))
#define XB_TOP      3328
#define XB_TOPGEN   3392
#define XCD_BAR_WORDS 3456
#define XB_SPIN_CAP (1u << 22)
constexpr int CW_BAR = 4096;

__device__ __forceinline__ unsigned xb_ld(unsigned* p)              { return __hip_atomic_load(p, __ATOMIC_RELAXED, __HIP_MEMORY_SCOPE_AGENT); }
__device__ __forceinline__ unsigned xb_add(unsigned* p, unsigned v) { return __hip_atomic_fetch_add(p, v, __ATOMIC_RELAXED, __HIP_MEMORY_SCOPE_AGENT); }
__device__ __forceinline__ unsigned xb_xcc_id() { return (unsigned)__builtin_amdgcn_s_getreg((3 << 11) | 20) & 0xFu; }
#define XB_SPIN(cond, bar) do { unsigned _sp = 0; while (cond) { __builtin_amdgcn_s_sleep(1); \
    if ((++_sp & 255u) == 0u) { if (xb_ld(&(bar)[XB_TMO])) break; if (_sp > XB_SPIN_CAP) { atomicAdd(&(bar)[XB_TMO], 1u); break; } } } } while (0)

struct XcdBarrier { unsigned* bar; unsigned x; volatile LAS unsigned* st; };

__device__ __forceinline__ XcdBarrier xcd_barrier_post(unsigned* bar, volatile LAS unsigned* st) {
    XcdBarrier b; b.bar = bar; b.x = xb_xcc_id(); b.st = st;
    if (threadIdx.x == 0) (void)xb_add(&bar[XB_XCNT(b.x)], 1u);
    return b;
}
__device__ __forceinline__ void xcd_barrier_complete(unsigned* bar, unsigned x, unsigned& nloc, unsigned& nx) {
    const unsigned G = gridDim.x * gridDim.y * gridDim.z;
    unsigned sum, cnt, mine, sp = 0u;
    for (;;) {
        sum = 0u; cnt = 0u; mine = 0u;
#pragma unroll
        for (unsigned j = 0; j < 16; ++j) { const unsigned c = xb_ld(&bar[XB_XCNT(j)]); sum += c; cnt += (c > 0u) ? 1u : 0u; mine = (j == x) ? c : mine; }
        if (sum == G) break;
        __builtin_amdgcn_s_sleep(1);
        if ((++sp & 255u) == 0u) { if (xb_ld(&bar[XB_TMO])) break; if (sp > XB_SPIN_CAP) { atomicAdd(&bar[XB_TMO], 1u); break; } }
    }
    nloc = mine > 0u ? mine : 1u; nx = cnt > 0u ? cnt : 1u;
}
__device__ __forceinline__ void xcd_barrier(const XcdBarrier& b) {
    asm volatile("s_waitcnt vmcnt(0)" ::: "memory");
    __syncthreads();
    if (threadIdx.x == 0) {
        unsigned* bar = b.bar;
        __builtin_amdgcn_s_waitcnt(0);
        unsigned nloc = b.st[0], nx = b.st[1];
        if (nloc == 0u) { xcd_barrier_complete(bar, b.x, nloc, nx); b.st[0] = nloc; b.st[1] = nx; }
        const unsigned old = xb_add(&bar[XB_XSUB(b.x)], 1u);
        const unsigned gen = old / nloc;
        if (old + 1u == (gen + 1u) * nloc) {
            __builtin_amdgcn_fence(__ATOMIC_RELEASE, "agent");
            asm volatile("s_waitcnt vmcnt(0)" ::: "memory");
            const unsigned og = xb_add(&bar[XB_TOP], 1u);
            const unsigned tg = og / nx;
            if (og + 1u == (tg + 1u) * nx) xb_add(&bar[XB_TOPGEN], 1u);
            else XB_SPIN(xb_ld(&bar[XB_TOPGEN]) == tg, bar);
            __builtin_amdgcn_fence(__ATOMIC_ACQUIRE, "agent");
            xb_add(&bar[XB_XGEN(b.x)], 1u);
            asm volatile("s_waitcnt vmcnt(0)" ::: "memory");
        } else {
            XB_SPIN(xb_ld(&bar[XB_XGEN(b.x)]) == gen, bar);
            __builtin_amdgcn_fence(__ATOMIC_ACQUIRE, "agent");
            asm volatile("s_waitcnt vmcnt(0)" ::: "memory");
        }
    }
    __syncthreads();
}

struct Frame {
    LAS unsigned char* lds;
    volatile LAS unsigned* MISC;
    gu32* ctl;
    int tid, lane, wave, vcu, G;
    const float *x, *meta, *norm_g, *w_in, *b_gate, *conv_a_w, *w_proj_a, *conv_b_w, *conv_b_b, *w_rg_a, *b_rg_a, *w_rg_i, *b_rg_i, *lru, *w_proj_b, *w_out, *fin_g;
    float* out; float* RS;
    bf16_t *WinT, *WabT, *WoutT, *WgaT, *WgiT;
    bf16_t *XN, *PB, *XB, *UV, *GR, *GB;
};

__device__ __forceinline__ float wave_sum(float v) {
#pragma unroll
    for (int o = 1; o < 64; o <<= 1) v += __shfl_xor(v, o);
    return v;
}

template <class FMap>
__device__ __forceinline__ void p0_transpose_item(const float* W, int Nsrc, bf16_t* WT, int ldo, int col_off, LAS float* scr, int kb, int nb, int lane, FMap fmap) {
    const int k0 = 64 * kb, n0 = 32 * nb;
    const int fsrc = fmap(n0 + (lane & 31));
#pragma unroll 8
    for (int i = 0; i < 32; ++i) { const int kk = 2 * i + (lane >> 5); scr[kk * 33 + (lane & 31)] = W[(size_t)(k0 + kk) * Nsrc + fsrc]; }
    LDS_WAIT(); asm volatile("" ::: "memory");
    const int c = lane & 7;
#pragma unroll
    for (int j = 0; j < 4; ++j) { const int n = (lane >> 3) + 8 * j; const LAS float* s = scr + (8 * c) * 33 + n;
        u32x4 o; o.x = pk2(s[0 * 33], s[1 * 33]); o.y = pk2(s[2 * 33], s[3 * 33]); o.z = pk2(s[4 * 33], s[5 * 33]); o.w = pk2(s[6 * 33], s[7 * 33]);
        *(GAS u32x4*)(WT + (size_t)(n0 + n) * ldo + col_off + k0 + 8 * c) = o; }
    LDS_WAIT(); asm volatile("" ::: "memory");
}
struct FIdent { __device__ __forceinline__ int operator()(int n) const { return n; } };
struct FWin {
    __device__ __forceinline__ int operator()(int np) const {
        const int pn = np >> 8, s = np & 255, type = pn & 1, cb = pn >> 1;
        const int bj = s >> 7, wc = (s >> 5) & 3, n = (s >> 4) & 1, fq = (s >> 2) & 3, j = s & 3;
        return (type * 4 + 2 * bj + n) * 1024 + cb * 64 + wc * 16 + fq * 4 + j;
    }
};

__device__ __forceinline__ void rms_row_to_bf16(const float* xrow, const float* g, bf16_t* orow, int lane) {
    const GAS f32x4* xr = (const GAS f32x4*)xrow + lane; const GAS f32x4* gr = (const GAS f32x4*)g + lane;
    f32x4 v[4]; float s = 0.f;
#pragma unroll
    for (int j = 0; j < 4; ++j) { v[j] = xr[64 * j]; s += (v[j].x * v[j].x + v[j].y * v[j].y) + (v[j].z * v[j].z + v[j].w * v[j].w); }
    const float rstd = 1.0f / sqrtf(wave_sum(s) * (1.f / D) + RMS_EPS);
    GAS u32x2* o8 = (GAS u32x2*)orow + lane;
#pragma unroll
    for (int j = 0; j < 4; ++j) { const f32x4 gg = gr[64 * j]; u32x2 w; w.x = pk2(v[j].x * rstd * gg.x, v[j].y * rstd * gg.y); w.y = pk2(v[j].z * rstd * gg.z, v[j].w * rstd * gg.w); o8[64 * j] = w; }
}

__device__ __forceinline__ void p0_prologue(Frame& F) {
    LAS float* scr = (LAS float*)(F.lds + RING_OFF + F.wave * 16384);
    const int gw = F.vcu * NWAVES + F.wave, NGW = F.G * NWAVES;
    constexpr int I_IN = 16 * 256, I_P = 16 * 32, I_G = 4 * 4 * 8;
    constexpr int NITEMS = I_IN + 3 * I_P + 2 * I_G;
    for (int it = gw; it < NITEMS; it += NGW) {
        int r = it;
        if (r < I_IN) { p0_transpose_item(F.w_in, NIN, F.WinT, 1024, 0, scr, r / 256, r % 256, F.lane, FWin()); continue; } r -= I_IN;
        if (r < I_P) { p0_transpose_item(F.w_proj_a, 1024, F.WabT, 2048, 0, scr, r / 32, r % 32, F.lane, FIdent()); continue; } r -= I_P;
        if (r < I_P) { p0_transpose_item(F.w_proj_b, 1024, F.WabT, 2048, 1024, scr, r / 32, r % 32, F.lane, FIdent()); continue; } r -= I_P;
        if (r < I_P) { p0_transpose_item(F.w_out, 1024, F.WoutT, 1024, 0, scr, r / 32, r % 32, F.lane, FIdent()); continue; } r -= I_P;
        if (r < I_G) { const int h = r / 32, q = r % 32; p0_transpose_item(F.w_rg_a + (size_t)h * 65536, 256, F.WgaT + (size_t)h * 65536, 256, 0, scr, q / 8, q % 8, F.lane, FIdent()); continue; } r -= I_G;
        { const int h = r / 32, q = r % 32; p0_transpose_item(F.w_rg_i + (size_t)h * 65536, 256, F.WgiT + (size_t)h * 65536, 256, 0, scr, q / 8, q % 8, F.lane, FIdent()); }
    }
    for (int m = gw; m < MP; m += NGW) {
        bf16_t* orow = F.XN + (size_t)m * D;
        if (m < MR) rms_row_to_bf16(F.x + (size_t)m * D, F.norm_g, orow, F.lane);
        else if (m < MR + NMETA) rms_row_to_bf16(F.meta + (size_t)(m - MR) * D, F.norm_g, orow, F.lane);
        else { GAS u32x4* o = (GAS u32x4*)orow + F.lane; o[0] = (u32x4){0u, 0u, 0u, 0u}; o[64] = (u32x4){0u, 0u, 0u, 0u}; }
    }
}

__device__ __forceinline__ int prev_row(int row, int k) {
    if (row >= MR) { const int m = row - MR; return m >= k ? row - k : -1; }
    const int s = row & (SEQ - 1); return s >= k ? row - k : MR + NMETA + (s - k);
}
__device__ __forceinline__ void unpack8(const u32x4 w, float (&f)[8]) { f[0] = bf_lo(w.x); f[1] = bf_hi(w.x); f[2] = bf_lo(w.y); f[3] = bf_hi(w.y); f[4] = bf_lo(w.z); f[5] = bf_hi(w.z); f[6] = bf_lo(w.w); f[7] = bf_hi(w.w); }
__device__ __forceinline__ void p1b_conv(Frame& F) {
    const int gt = F.vcu * (NWAVES * 64) + F.tid, NT = F.G * NWAVES * 64;
    constexpr int NITEMS = (MR + NMETA) * 128;
    bf16_t* XC = F.XN;
    for (int it = gt; it < NITEMS; it += NT) {
        const int row = it >> 7, ch = (it & 127) * 8;
        const int r1 = prev_row(row, 1), r2 = prev_row(row, 2), r3 = prev_row(row, 3);
        const u32x4 z4 = (u32x4){0u, 0u, 0u, 0u};
        const u32x4 p0 = *(const GAS u32x4*)(F.PB + (size_t)row * 1024 + ch);
        const u32x4 p1 = r1 >= 0 ? *(const GAS u32x4*)(F.PB + (size_t)r1 * 1024 + ch) : z4;
        const u32x4 p2 = r2 >= 0 ? *(const GAS u32x4*)(F.PB + (size_t)r2 * 1024 + ch) : z4;
        const u32x4 qq = *(const GAS u32x4*)(F.UV + (size_t)row * 2048 + ch);
        const u32x4 x0 = *(const GAS u32x4*)(F.XB + (size_t)row * 1024 + ch);
        const u32x4 x1 = r1 >= 0 ? *(const GAS u32x4*)(F.XB + (size_t)r1 * 1024 + ch) : z4;
        const u32x4 x2 = r2 >= 0 ? *(const GAS u32x4*)(F.XB + (size_t)r2 * 1024 + ch) : z4;
        const u32x4 x3 = r3 >= 0 ? *(const GAS u32x4*)(F.XB + (size_t)r3 * 1024 + ch) : z4;
        float fp0[8], fp1[8], fp2[8], fq[8], fx0[8], fx1[8], fx2[8], fx3[8];
        unpack8(p0, fp0); unpack8(p1, fp1); unpack8(p2, fp2); unpack8(qq, fq); unpack8(x0, fx0); unpack8(x1, fx1); unpack8(x2, fx2); unpack8(x3, fx3);
        float ua[8], xc[8];
#pragma unroll
        for (int j = 0; j < 8; ++j) {
            const int c = ch + j;
            const float wa0 = F.conv_a_w[c], wa1 = F.conv_a_w[1024 + c], wa2 = F.conv_a_w[2048 + c];
            const float wb0 = F.conv_b_w[c], wb1 = F.conv_b_w[1024 + c], wb2 = F.conv_b_w[2048 + c], wb3 = F.conv_b_w[3072 + c];
            float ca = fp2[j] * wa0; ca = ca + fp1[j] * wa1; ca = ca + fp0[j] * wa2;
            ua[j] = fq[j] * ca;
            float cb = fx3[j] * wb0; cb = cb + fx2[j] * wb1; cb = cb + fx1[j] * wb2; cb = cb + fx0[j] * wb3;
            xc[j] = cb + F.conv_b_b[c];
        }
        u32x4 o1, o2;
        o1.x = pk2(ua[0], ua[1]); o1.y = pk2(ua[2], ua[3]); o1.z = pk2(ua[4], ua[5]); o1.w = pk2(ua[6], ua[7]);
        o2.x = pk2(xc[0], xc[1]); o2.y = pk2(xc[2], xc[3]); o2.z = pk2(xc[4], xc[5]); o2.w = pk2(xc[6], xc[7]);
        *(GAS u32x4*)(F.UV + (size_t)row * 2048 + ch) = o1;
        *(GAS u32x4*)(XC + (size_t)row * 1024 + ch) = o2;
    }
}

constexpr int P2_W_BYTES = 65536, P2_AGG_OFF = 65536;

__device__ __forceinline__ int tok_of(int rho, int hh) { return (rho & 3) + 8 * (rho >> 2) + 4 * hh; }

template <bool META>
__device__ __forceinline__ void p2_slab(LAS const unsigned char* wl, const bf16_t* XC, int R0, int kbase, int chb, int lane,
                                        const float (&ba)[2], const float (&bi)[2], const float (&nsp)[2],
                                        float (&cumA)[2][16], float (&hloc)[2][16]) {
    const int c = lane & 31, hh = lane >> 5;
    const int rowA = META ? MR + (c & 15) : R0 + c;
    const int rowbase = META ? MR - 16 : R0;
    const GAS bf16x8* ap = (const GAS bf16x8*)(XC + (size_t)rowA * 1024 + kbase + 8 * hh);
    f32x16 acc[4];
#pragma unroll
    for (int s = 0; s < 4; ++s)
#pragma unroll
        for (int r = 0; r < 16; ++r) acc[s][r] = 0.f;
    const unsigned rowoff = (unsigned)c * 512u; const int x15 = lane & 15;
#pragma unroll
    for (int kh = 0; kh < 2; ++kh) {
        bf16x8 af[8];
#pragma unroll
        for (int k8 = 0; k8 < 8; ++k8) af[k8] = ap[2 * (8 * kh + k8)];
#pragma unroll
        for (int k8 = 0; k8 < 8; ++k8) { const int ks = 8 * kh + k8;
            const unsigned boff = rowoff + ((unsigned)((2 * ks + hh) ^ x15) << 4);
#pragma unroll
            for (int s = 0; s < 4; ++s) { const bf16x8 b = *(const LAS bf16x8*)(wl + boff + s * 16384);
                acc[s] = __builtin_amdgcn_mfma_f32_32x32x16_bf16(af[k8], b, acc[s], 0, 0, 0); }
        }
        asm volatile("" ::: "memory");
    }
    unsigned xcv[16];
#pragma unroll
    for (int rho = 0; rho < 16; ++rho) { if (META && rho < 8) { xcv[rho] = 0u; continue; }
        xcv[rho] = *(const GAS unsigned*)(XC + (size_t)(rowbase + tok_of(rho, hh)) * 1024 + chb + 2 * c); }
#pragma unroll
    for (int s2 = 0; s2 < 2; ++s2)
#pragma unroll
        for (int rho = 0; rho < 16; ++rho) {
            if (META && rho < 8) { cumA[s2][rho] = 1.f; hloc[s2][rho] = 0.f; continue; }
            const float r = fsigmoid(acc[s2][rho] + ba[s2]);
            const float ig = fsigmoid(acc[2 + s2][rho] + bi[s2]);
            const float la = nsp[s2] * r;
            const float a = __builtin_amdgcn_exp2f(la * L2E);
            const float y = 2.f * la;
            const float om_ser = -y * (1.f + y * (0.5f + y * (0.16666667f + y * 0.041666667f)));
            const float om = (y > -0.05f) ? om_ser : (1.f - a * a);
            float mult = __builtin_amdgcn_sqrtf(om);
            if (META && rho == 8) mult = (hh == 0) ? 1.f : mult;
            const float xc = s2 ? bf_hi(xcv[rho]) : bf_lo(xcv[rho]);
            cumA[s2][rho] = a; hloc[s2][rho] = xc * ig * mult;
        }
#pragma unroll
    for (int s2 = 0; s2 < 2; ++s2)
#pragma unroll
        for (int g = 0; g < 4; ++g) { const int b = 4 * g;
            hloc[s2][b + 1] = cumA[s2][b + 1] * hloc[s2][b] + hloc[s2][b + 1];
            hloc[s2][b + 2] = cumA[s2][b + 2] * hloc[s2][b + 1] + hloc[s2][b + 2];
            hloc[s2][b + 3] = cumA[s2][b + 3] * hloc[s2][b + 2] + hloc[s2][b + 3];
            cumA[s2][b + 1] *= cumA[s2][b]; cumA[s2][b + 2] *= cumA[s2][b + 1]; cumA[s2][b + 3] *= cumA[s2][b + 2]; }
}

__device__ __forceinline__ void p2_group_prefix(const float (&cumA)[2][16], const float (&hloc)[2][16], int hh, float (&exP)[2][4], float (&exS)[2][4], float (&slP)[2], float (&slS)[2]) {
#pragma unroll
    for (int s2 = 0; s2 < 2; ++s2) {
        float runP = 1.f, runS = 0.f;
#pragma unroll
        for (int g = 0; g < 4; ++g) {
            const auto pp = __builtin_amdgcn_permlane32_swap(__float_as_uint(cumA[s2][4 * g + 3]), __float_as_uint(cumA[s2][4 * g + 3]), false, false);
            const auto ss = __builtin_amdgcn_permlane32_swap(__float_as_uint(hloc[s2][4 * g + 3]), __float_as_uint(hloc[s2][4 * g + 3]), false, false);
            const float Pe = __uint_as_float(pp[0]), Po = __uint_as_float(pp[1]), Se = __uint_as_float(ss[0]), So = __uint_as_float(ss[1]);
            const float ePe = runP, eSe = runS; runS = Pe * runS + Se; runP = Pe * runP;
            const float ePo = runP, eSo = runS; runS = Po * runS + So; runP = Po * runP;
            exP[s2][g] = hh ? ePo : ePe; exS[s2][g] = hh ? eSo : eSe;
        }
        slP[s2] = runP; slS[s2] = runS;
    }
}

__device__ __forceinline__ void p2_scan(Frame& F) {
    LAS unsigned char* wl = F.lds + RING_OFF;
    LAS float* agg = (LAS float*)(F.lds + RING_OFF + P2_AGG_OFF);
    const bf16_t* XC = F.XN;
    const int lane = F.lane, c = lane & 31, hh = lane >> 5, w = F.wave;
    for (int chain = F.vcu; chain < NBATCH * 16; chain += F.G) {
        const int cg = chain & 3, head = (chain >> 2) & 3, b = chain >> 4;
        const int kbase = head * 256, chb = head * 256 + cg * 64;
        __syncthreads();
        for (int idx = F.tid; idx < 128 * 32; idx += NWAVES * 64) {
            const int n = idx >> 5, q = idx & 31, s = n >> 5, cc = n & 31;
            const int chl = 2 * cc + (s & 1);
            const bf16_t* src = ((s < 2) ? F.WgaT : F.WgiT) + (size_t)head * 65536 + (size_t)(cg * 64 + chl) * 256 + q * 8;
            *(LAS u32x4*)(wl + n * 512 + ((q ^ (n & 15)) << 4)) = *(const GAS u32x4*)src;
        }
        float ba[2], bi[2], nsp[2];
#pragma unroll
        for (int s2 = 0; s2 < 2; ++s2) { const int ch = chb + 2 * c + s2; ba[s2] = F.b_rg_a[ch]; bi[s2] = F.b_rg_i[ch]; nsp[s2] = -8.0f * log1pf(expf(-F.lru[ch])); }
        LDS_WAIT();
        __syncthreads();
        float carry[2];
        float cumA[2][16], hloc[2][16], exP[2][4], exS[2][4], slP[2], slS[2];
        p2_slab<true>(wl, XC, 0, kbase, chb, lane, ba, bi, nsp, cumA, hloc);
        p2_group_prefix(cumA, hloc, hh, exP, exS, slP, slS);
        carry[0] = slS[0]; carry[1] = slS[1];
        for (int j = 0; j < SEQ / 256; ++j) {
            const int R0 = b * SEQ + j * 256 + w * 32;
            p2_slab<false>(wl, XC, R0, kbase, chb, lane, ba, bi, nsp, cumA, hloc);
            unsigned szv[16];
#pragma unroll
            for (int rho = 0; rho < 16; ++rho) szv[rho] = *(const GAS unsigned*)(F.UV + (size_t)(R0 + tok_of(rho, hh)) * 2048 + 1024 + chb + 2 * c);
            p2_group_prefix(cumA, hloc, hh, exP, exS, slP, slS);
            LAS float* ag = agg + (j & 1) * 1024;
            if (hh == 0) *(LAS f32x4*)(ag + w * 128 + c * 4) = (f32x4){slP[0], slS[0], slP[1], slS[1]};
            LDS_WAIT();
            __syncthreads();
            float cs[2] = {carry[0], carry[1]}, run[2] = {carry[0], carry[1]};
#pragma unroll
            for (int ww = 0; ww < 8; ++ww) { const f32x4 e = *(const LAS f32x4*)(ag + ww * 128 + c * 4);
                if (ww == w) { cs[0] = run[0]; cs[1] = run[1]; }
                run[0] = e[0] * run[0] + e[1]; run[1] = e[2] * run[1] + e[3]; }
            carry[0] = run[0]; carry[1] = run[1];
#pragma unroll
            for (int g = 0; g < 4; ++g) {
                const float cg0 = exP[0][g] * cs[0] + exS[0][g], cg1 = exP[1][g] * cs[1] + exS[1][g];
#pragma unroll
                for (int t = 0; t < 4; ++t) { const int rho = 4 * g + t;
                    const float h0 = hloc[0][rho] + cumA[0][rho] * cg0, h1 = hloc[1][rho] + cumA[1][rho] * cg1;
                    const unsigned o = cvt_pk_bf16(h0 * bf_lo(szv[rho]), h1 * bf_hi(szv[rho]));
                    *(GAS unsigned*)(F.UV + (size_t)(R0 + tok_of(rho, hh)) * 2048 + 1024 + chb + 2 * c) = o; }
            }
        }
    }
    __syncthreads();
}

__device__ __forceinline__ void p5_final(Frame& F) {
    const int gw = F.vcu * NWAVES + F.wave, NGW = F.G * NWAVES;
    for (int m = gw; m < MR; m += NGW) {
        const float rstd = 1.0f / sqrtf(F.RS[m] * (1.f / D) + RMS_EPS);
        GAS f32x4* o = (GAS f32x4*)(F.out + (size_t)m * D) + F.lane; const GAS f32x4* gr = (const GAS f32x4*)F.fin_g + F.lane;
#pragma unroll
        for (int j = 0; j < 4; ++j) { const f32x4 v = o[64 * j], gg = gr[64 * j]; o[64 * j] = v * rstd * gg; }
    }
}

constexpr int PER_PHASE = 7;
constexpr int N_LAUNCHES = MK_N_LAUNCHES;
struct Args { const float* in[17]; float* out; unsigned char* ws; int ph_lo, ph_hi, li, pad; };

__global__ void __launch_bounds__(NWAVES * 64, 2) hybrid_fwd(Args args) {
    extern __shared__ __attribute__((aligned(16))) unsigned char lds[];
    Frame F;
    F.lds = (LAS unsigned char*)lds;
    F.MISC = (volatile LAS unsigned*)(F.lds + MISC_OFF);
    F.tid = threadIdx.x; F.lane = F.tid & 63; F.wave = __builtin_amdgcn_readfirstlane(F.tid >> 6);
    F.G = gridDim.x; { const int bx = blockIdx.x; F.vcu = (F.G % 8 == 0) ? (bx % 8) * (F.G / 8) + bx / 8 : bx; }
    unsigned char* ws = args.ws;
    F.ctl = (gu32*)(ws + WS_CTL);
    F.x = args.in[0]; F.meta = args.in[1]; F.norm_g = args.in[2]; F.w_in = args.in[3]; F.b_gate = args.in[4]; F.conv_a_w = args.in[5]; F.w_proj_a = args.in[6];
    F.conv_b_w = args.in[7]; F.conv_b_b = args.in[8]; F.w_rg_a = args.in[9]; F.b_rg_a = args.in[10]; F.w_rg_i = args.in[11]; F.b_rg_i = args.in[12]; F.lru = args.in[13];
    F.w_proj_b = args.in[14]; F.w_out = args.in[15]; F.fin_g = args.in[16];
    F.out = args.out; F.RS = (float*)(ws + WS_RS);
    F.WinT = (bf16_t*)(ws + WS_WIN); F.WabT = (bf16_t*)(ws + WS_WAB); F.WoutT = (bf16_t*)(ws + WS_WOUT); F.WgaT = (bf16_t*)(ws + WS_WGA); F.WgiT = (bf16_t*)(ws + WS_WGI);
    F.XN = (bf16_t*)(ws + WS_XN); F.PB = (bf16_t*)(ws + WS_PB); F.XB = (bf16_t*)(ws + WS_XB); F.UV = (bf16_t*)(ws + WS_UV); F.GR = (bf16_t*)(ws + WS_GR); F.GB = (bf16_t*)(ws + WS_GB);
    for (int u = F.tid; u < (LDS_BYTES - LDSCTL_OFF) / 4; u += NWAVES * 64) ((LAS unsigned*)(F.lds + LDSCTL_OFF))[u] = 0u;
    __syncthreads();
    XcdBarrier bar; bar.bar = (unsigned*)(F.ctl + CW_BAR); bar.x = 0; bar.st = nullptr;
    if (N_LAUNCHES != PER_PHASE) bar = xcd_barrier_post((unsigned*)(F.ctl + CW_BAR), F.MISC + 8);
#define GRID_BAR() do { if (N_LAUNCHES != PER_PHASE) xcd_barrier(bar); } while (0)
    const int lo = args.ph_lo, hi = args.ph_hi;
#define IN(k) (lo <= (k) && (k) < hi)
#define BOTH(k) (IN(k) && IN((k) + 1))

    if (IN(0)) { p0_prologue(F); if (BOTH(0)) GRID_BAR(); }

    if (IN(1)) {
        pg8::Gemm g{F.XN, F.WinT, 1024, 1024, 1024}; pg8::StaticOrder S; S.init(MP / 256, NIN / 256, F.G, (int)blockIdx.x);
        EpiP1 E{F.PB, F.UV, F.XB, F.GR, F.GB, F.b_gate};
        pg8::gemm_phase<EpiP1, pg8::StaticOrder, true, true>(F.lds + RING_OFF, g, S, E);
        if (BOTH(1)) GRID_BAR();
    }

    if (IN(2)) { p1b_conv(F); if (BOTH(2)) GRID_BAR(); }

    if (IN(3)) { p2_scan(F); if (BOTH(3)) GRID_BAR(); }

    if (IN(4)) {
        pg8::Gemm g{F.UV, F.WabT, 2048, 2048, 2048}; pg8::StaticOrder S; S.init(MR / 256, 4, F.G, (int)blockIdx.x);
        EpiP3 E{F.GR, F.GB, F.PB};
        pg8::gemm_phase<EpiP3, pg8::StaticOrder, true, true>(F.lds + RING_OFF, g, S, E);
        if (BOTH(4)) GRID_BAR();
    }

    if (IN(5)) {
        pg8::Gemm g{F.PB, F.WoutT, 1024, 1024, 1024}; pg8::StaticOrder S; S.init(MR / 256, 4, F.G, (int)blockIdx.x);
        EpiP4 E{F.x, F.out, F.RS};
        pg8::gemm_phase<EpiP4, pg8::StaticOrder, true, true>(F.lds + RING_OFF, g, S, E);
        if (BOTH(5)) GRID_BAR();
    }

    if (IN(6)) { p5_final(F); }
#undef IN
#undef BOTH
#undef GRID_BAR
}

extern "C" void kernel_launch(void* const* d_in, const int* in_sizes, int n_in, void* d_out, int out_size, void* d_ws, size_t ws_size, hipStream_t stream) {
    static int grid = 0;
    if (grid == 0) {
        if (n_in != 17 || in_sizes[0] != MR * D || out_size != MR * D || ws_size < WS_END) {
            fprintf(stderr, "kernel_launch: unexpected shapes: n_in %d in0 %d out %d ws %zu (need %zu)\n", n_in, n_in > 0 ? in_sizes[0] : -1, out_size, ws_size, (size_t)WS_END); grid = -1; return; }
        int dev = 0, cus = 0, per_cu = 0;
        if (hipGetDevice(&dev) != hipSuccess || hipDeviceGetAttribute(&cus, hipDeviceAttributeMultiprocessorCount, dev) != hipSuccess) { fprintf(stderr, "kernel_launch: device query failed\n"); grid = -1; return; }
        if (hipFuncSetAttribute((const void*)hybrid_fwd, hipFuncAttributeMaxDynamicSharedMemorySize, LDS_BYTES) != hipSuccess) { fprintf(stderr, "kernel_launch: hipFuncSetAttribute failed\n"); grid = -1; return; }
        if (hipOccupancyMaxActiveBlocksPerMultiprocessor(&per_cu, (const void*)hybrid_fwd, NWAVES * 64, LDS_BYTES) != hipSuccess || per_cu < 1) {
            fprintf(stderr, "kernel_launch: occupancy query reports %d blocks per CU\n", per_cu); (void)hipGetLastError(); grid = -1; return; }
        (void)hipGetLastError();
        grid = cus;
    }
    if (grid < 0) return;
    if (hipMemsetAsync((char*)d_ws + WS_CTL, 0, CTL_ZERO_BYTES, stream) != hipSuccess) { fprintf(stderr, "kernel_launch: memset failed\n"); return; }
    Args a{};
    for (int i = 0; i < 17; ++i) a.in[i] = (const float*)d_in[i];
    a.out = (float*)d_out; a.ws = (unsigned char*)d_ws;
    for (int li = 0; li < N_LAUNCHES; ++li) {
        a.ph_lo = (N_LAUNCHES == PER_PHASE) ? li : 0; a.ph_hi = (N_LAUNCHES == PER_PHASE) ? li + 1 : PER_PHASE; a.li = li;
        hipLaunchKernelGGL(hybrid_fwd, dim3(grid), dim3(NWAVES * 64), LDS_BYTES, stream, a);
        const hipError_t le = hipPeekAtLastError();
        if (le != hipSuccess) { fprintf(stderr, "kernel_launch: launch %d failed: %s\n", li, hipGetErrorName(le)); break; }
    }
}
```

```cpp
#include <hip/hip_runtime.h>
#include <cstdio>
#include <cstdint>

#ifndef MK_N_LAUNCHES
#define MK_N_LAUNCHES 1
#endif

#define LAS __attribute__((address_space(3)))
#define GAS __attribute__((address_space(1)))
typedef unsigned short bf16_t;
typedef short bf16x8 __attribute__((ext_vector_type(8)));
typedef float f32x4 __attribute__((ext_vector_type(4)));
typedef float f32x16 __attribute__((ext_vector_type(16)));
typedef unsigned u32x4 __attribute__((ext_vector_type(4)));
typedef unsigned u32x2 __attribute__((ext_vector_type(2)));

constexpr int D = 1024, NBATCH = 16, SEQ = 4096, NMETA = 16, NIN = 8192;
constexpr int MR = NBATCH * SEQ;
constexpr int MP = MR + 256;
constexpr float RMS_EPS = 1e-6f;
constexpr float L2E = 1.4426950408889634f;

constexpr size_t MiB = 1u << 20;
constexpr size_t WS_CTL = 0, CTL_ZERO_BYTES = 1 * MiB;
constexpr size_t WS_RS = 512 * 1024;
constexpr size_t WS_WIN = 2 * MiB;
constexpr size_t WS_WAB = 18 * MiB;
constexpr size_t WS_WOUT = 22 * MiB;
constexpr size_t WS_WGA = 24 * MiB;
constexpr size_t WS_WGI = WS_WGA + 512 * 1024;
constexpr size_t ACT = 129 * MiB;
constexpr size_t WS_XN = 32 * MiB;
constexpr size_t WS_PB = WS_XN + ACT;
constexpr size_t WS_XB = WS_PB + ACT;
constexpr size_t WS_UV = WS_XB + ACT;
constexpr size_t WS_GR = WS_UV + 2 * ACT;
constexpr size_t WS_GB = WS_GR + ACT;
constexpr size_t WS_END = WS_GB + ACT;
static_assert((size_t)MP * 1024 * 2 <= ACT, "activation slot");
static_assert(WS_END <= 1024 * MiB, "workspace");

namespace pg8 {
constexpr int BM = 256, BK = 64, HALF = 128, HTB = HALF * BK * 2, STAGE_BYTES = 8 * HTB, NXCD = 8, WGM = 8;

__host__ __device__ __forceinline__ int lds_byte(int r, int c) { const int st = (r >> 4) * 2 + (c >> 5), rr = r & 15, cc = c & 31, ob = rr * 64 + cc * 2; return st * 1024 + (ob ^ (((ob >> 9) & 1) << 5)); }
__host__ __device__ __forceinline__ void stage_rc(int b, int& R, int& C) { const int st = b / 1024, sb = b % 1024, swz = sb ^ (((sb >> 9) & 1) << 5); R = (st >> 1) * 16 + swz / 64; C = (st & 1) * 32 + (swz % 64) / 2; }
__host__ __device__ __forceinline__ int perm32(int rho) { const int n = rho >> 4, i = rho & 15; return 8 * (i >> 2) + 4 * n + (i & 3); }

struct Unit { int pm, pn; };
struct Gemm { const bf16_t* A; const bf16_t* Bt; int lda, ldb, K; };

struct StaticOrder {
    int nM, nN, nwg, G, c;
    __host__ __device__ void init(int nM_, int nN_, int G_, int c_) { nM = nM_; nN = nN_; nwg = nM * nN; G = G_; c = c_; }
    __host__ __device__ bool next(int i, Unit& u) const {
        const long L = (long)i * G + c; if (L >= nwg) return false;
        int wgid = (int)L; { const int q = nwg / NXCD, r = nwg % NXCD, xcd = wgid % NXCD, off = wgid / NXCD; wgid = (xcd < r ? xcd * (q + 1) : r * (q + 1) + (xcd - r) * q) + off; }
        const int nig = WGM * nN, gid = wgid / nig, fm = gid * WGM, gsz = (nM - fm) < WGM ? (nM - fm) : WGM;
        u.pm = fm + ((wgid % nig) % gsz); u.pn = (wgid % nig) / gsz; return true;
    }
    __device__ __forceinline__ void a_ready(const Unit&) const {}
    __device__ __forceinline__ void done(const Unit&) const {}
};

__device__ __forceinline__ unsigned cvt_pk_bf16(float lo, float hi) { unsigned r; asm volatile("v_cvt_pk_bf16_f32 %0, %1, %2" : "=v"(r) : "v"(lo), "v"(hi)); return r; }

template <class Epi, class Sched, bool ALIGN_EPI = false, bool SP2 = false>
__device__ __forceinline__ void gemm_phase(LAS unsigned char* lds, const Gemm g, const Sched& S, const Epi& E) {
    const int tid = threadIdx.x, wid = __builtin_amdgcn_readfirstlane(tid >> 6), lane = tid & 63, wr = wid >> 2, wc = wid & 3, fr = lane & 15, fq = lane >> 4;
    const int K = g.K, nt = K / BK;
    unsigned voffA[2], voffB[2];
#pragma unroll
    for (int i = 0; i < 2; ++i) { int R, C; stage_rc(tid * 16 + i * 8192, R, C); const int Rb = Epi::PERM ? ((R & ~31) + perm32(R & 31)) : R;
        voffA[i] = (unsigned)(R * g.lda + C) * 2u; voffB[i] = (unsigned)(Rb * g.ldb + C) * 2u; }
    const size_t kstep = (size_t)(BK * 2);
    const size_t hstepA = (size_t)HALF * g.lda * 2, hstepB = (size_t)HALF * g.ldb * 2;
    const size_t tstepA = 2 * hstepA, tstepB = 2 * hstepB;
    const unsigned ldsw = (unsigned)wid * 1024u;
    const int aoff = lds_byte(wr * 64 + fr, fq * 8), boff = lds_byte(wc * 32 + fr, fq * 8);
#define PG8_SA(b, h) (((b) * 2 + (h)) * HTB)
#define PG8_SB(b, h) ((4 + (b) * 2 + (h)) * HTB)
#define PG8_STAGE(bufoff, gbase, voff) do { _Pragma("unroll") for (int _i = 0; _i < 2; ++_i) \
        __builtin_amdgcn_global_load_lds((const unsigned*)((const char*)(gbase) + (voff)[_i]), (LAS unsigned*)(lds + (bufoff) + ldsw + _i * 8192), 16, 0, 0); } while (0)
#define PG8_LDA(dst, b, h) do { _Pragma("unroll") for (int m = 0; m < 4; ++m) _Pragma("unroll") for (int k = 0; k < 2; ++k) dst[m][k] = *(const LAS bf16x8*)(lds + PG8_SA(b, h) + aoff + m * 2048 + k * 1024); } while (0)
#define PG8_LDB(dst, b, h) do { _Pragma("unroll") for (int n = 0; n < 2; ++n) _Pragma("unroll") for (int k = 0; k < 2; ++k) dst[n][k] = *(const LAS bf16x8*)(lds + PG8_SB(b, h) + boff + n * 2048 + k * 1024); } while (0)
#define PG8_MMA(ai, bj, At, Bt) do { __builtin_amdgcn_s_setprio(1); _Pragma("unroll") for (int m = 0; m < 4; ++m) _Pragma("unroll") for (int n = 0; n < 2; ++n) _Pragma("unroll") for (int k = 0; k < 2; ++k) \
        acc[ai][bj][m][n] = __builtin_amdgcn_mfma_f32_16x16x32_bf16(Bt[n][k], At[m][k], acc[ai][bj][m][n], 0, 0, 0); __builtin_amdgcn_s_setprio(0); } while (0)
#define PG8_WAIT_V(n) asm volatile("s_waitcnt vmcnt(" #n ")" ::: "memory")
#define PG8_WAIT_L(n) asm volatile("s_waitcnt lgkmcnt(" #n ")" ::: "memory")
#define PG8_BAR __builtin_amdgcn_s_barrier()
#define PG8_SCHED __builtin_amdgcn_sched_barrier(0)
    Unit cur, nxt; int ui = 0;
    if (!S.next(0, cur)) return;
    f32x4 acc[2][2][4][2];
#pragma unroll
    for (int a = 0; a < 2; ++a)
#pragma unroll
        for (int b = 0; b < 2; ++b)
#pragma unroll
            for (int m = 0; m < 4; ++m)
#pragma unroll
                for (int n = 0; n < 2; ++n) acc[a][b][m][n] = (f32x4){0.f, 0.f, 0.f, 0.f};
    bf16x8 At[4][2], B0[2][2], B1[2][2];
    const char* cA = (const char*)g.A + (size_t)cur.pm * tstepA; const char* cB = (const char*)g.Bt + (size_t)cur.pn * tstepB;
    S.a_ready(cur);
    if constexpr (SP2) {
        PG8_STAGE(PG8_SB(0, 0), cB, voffB); PG8_STAGE(PG8_SB(0, 1), cB + hstepB, voffB); PG8_STAGE(PG8_SA(0, 0), cA, voffA); PG8_STAGE(PG8_SA(0, 1), cA + hstepA, voffA);
        if (wr == 1) PG8_BAR;
        PG8_WAIT_V(2); PG8_BAR;
        PG8_STAGE(PG8_SB(1, 0), cB + kstep, voffB); PG8_STAGE(PG8_SA(1, 0), cA + kstep, voffA); PG8_STAGE(PG8_SB(1, 1), cB + hstepB + kstep, voffB);
        PG8_WAIT_V(6); PG8_BAR;
    } else {
        PG8_STAGE(PG8_SB(0, 0), cB, voffB); PG8_STAGE(PG8_SA(0, 0), cA, voffA); PG8_STAGE(PG8_SB(0, 1), cB + hstepB, voffB); PG8_STAGE(PG8_SA(0, 1), cA + hstepA, voffA);
        if (wr == 1) PG8_BAR;
        PG8_WAIT_V(4); PG8_BAR;
        PG8_STAGE(PG8_SB(1, 0), cB + kstep, voffB); PG8_STAGE(PG8_SA(1, 0), cA + kstep, voffA); PG8_STAGE(PG8_SB(1, 1), cB + hstepB + kstep, voffB);
        PG8_WAIT_V(6); PG8_BAR;
    }
    for (;;) {
        const bool has_next = S.next(ui + 1, nxt);
        const char* nA = has_next ? (const char*)g.A + (size_t)nxt.pm * tstepA : cA; const char* nB = has_next ? (const char*)g.Bt + (size_t)nxt.pn * tstepB : cB;
        for (int t = 0; t < nt; t += 2) {
            const bool last = (t == nt - 2);
            const char* a1 = cA + (size_t)(t + 1) * kstep;
            const char* a2 = last ? nA : cA + (size_t)(t + 2) * kstep; const char* b2 = last ? nB : cB + (size_t)(t + 2) * kstep;
            const char* a3 = a2 + kstep; const char* b3 = b2 + kstep;
            if constexpr (Epi::HAS_MID) { if (t == Epi::MID_T) E.mid(acc, cur, wr, wc, fr, fq); }
            if (last && has_next) S.a_ready(nxt);
            if constexpr (SP2) {
            PG8_LDB(B0, 0, 0); PG8_LDB(B1, 0, 1); PG8_SCHED; PG8_LDA(At, 0, 0); PG8_STAGE(PG8_SA(1, 1), a1 + hstepA, voffA);
            PG8_WAIT_V(8); PG8_WAIT_L(0); PG8_BAR; PG8_MMA(0, 0, At, B0); PG8_MMA(0, 1, At, B1); PG8_BAR; PG8_SCHED;
            PG8_LDA(At, 0, 1); PG8_STAGE(PG8_SB(0, 0), b2, voffB); PG8_STAGE(PG8_SB(0, 1), b2 + hstepB, voffB); PG8_STAGE(PG8_SA(0, 0), a2, voffA);
            PG8_WAIT_V(8); PG8_WAIT_L(0); PG8_BAR; PG8_MMA(1, 0, At, B0); PG8_MMA(1, 1, At, B1); PG8_BAR; PG8_SCHED;
            PG8_LDB(B0, 1, 0); PG8_LDB(B1, 1, 1); PG8_SCHED; PG8_LDA(At, 1, 0); PG8_STAGE(PG8_SA(0, 1), a2 + hstepA, voffA);
            PG8_WAIT_V(8); PG8_WAIT_L(0); PG8_BAR; PG8_MMA(0, 0, At, B0); PG8_MMA(0, 1, At, B1); PG8_BAR; PG8_SCHED;
            PG8_LDA(At, 1, 1); PG8_STAGE(PG8_SB(1, 0), b3, voffB); PG8_STAGE(PG8_SB(1, 1), b3 + hstepB, voffB); PG8_STAGE(PG8_SA(1, 0), a3, voffA);
            PG8_WAIT_V(8); PG8_WAIT_L(0); PG8_BAR; PG8_MMA(1, 0, At, B0); PG8_MMA(1, 1, At, B1); PG8_BAR; PG8_SCHED;
            } else {
            PG8_LDB(B0, 0, 0); PG8_SCHED; PG8_LDA(At, 0, 0); PG8_STAGE(PG8_SA(1, 1), a1 + hstepA, voffA);
            PG8_WAIT_L(8); PG8_BAR; PG8_WAIT_L(0); PG8_MMA(0, 0, At, B0); PG8_BAR; PG8_SCHED;
            PG8_LDB(B1, 0, 1); PG8_STAGE(PG8_SB(0, 0), b2, voffB);
            PG8_BAR; PG8_WAIT_L(0); PG8_MMA(0, 1, At, B1); PG8_BAR;
            PG8_LDA(At, 0, 1); PG8_STAGE(PG8_SA(0, 0), a2, voffA);
            PG8_BAR; PG8_WAIT_L(0); PG8_MMA(1, 0, At, B0); PG8_BAR; PG8_SCHED;
            PG8_STAGE(PG8_SB(0, 1), b2 + hstepB, voffB);
            PG8_WAIT_V(6); PG8_BAR; PG8_MMA(1, 1, At, B1); PG8_BAR;
            PG8_LDB(B0, 1, 0); PG8_SCHED; PG8_LDA(At, 1, 0); PG8_STAGE(PG8_SA(0, 1), a2 + hstepA, voffA);
            PG8_WAIT_L(8); PG8_BAR; PG8_WAIT_L(0); PG8_MMA(0, 0, At, B0); PG8_BAR; PG8_SCHED;
            PG8_LDB(B1, 1, 1); PG8_STAGE(PG8_SB(1, 0), b3, voffB);
            PG8_BAR; PG8_WAIT_L(0); PG8_MMA(0, 1, At, B1); PG8_BAR;
            PG8_LDA(At, 1, 1); PG8_STAGE(PG8_SA(1, 0), a3, voffA);
            PG8_BAR; PG8_WAIT_L(0); PG8_MMA(1, 0, At, B0); PG8_BAR; PG8_SCHED;
            PG8_STAGE(PG8_SB(1, 1), b3 + hstepB, voffB);
            PG8_WAIT_V(6); PG8_BAR; PG8_MMA(1, 1, At, B1); PG8_BAR;
            }
        }
        if constexpr (ALIGN_EPI) { if (wr == 0) PG8_BAR; }
        E(acc, cur, wr, wc, fr, fq); S.done(cur);
        if (!has_next) break;
#pragma unroll
        for (int a = 0; a < 2; ++a)
#pragma unroll
            for (int b = 0; b < 2; ++b)
#pragma unroll
                for (int m = 0; m < 4; ++m)
#pragma unroll
                    for (int n = 0; n < 2; ++n) acc[a][b][m][n] = (f32x4){0.f, 0.f, 0.f, 0.f};
        cur = nxt; cA = nA; cB = nB; ++ui;
        if constexpr (ALIGN_EPI) { if (wr == 1) PG8_BAR; }
    }
    PG8_WAIT_V(0);
    if constexpr (!ALIGN_EPI) { if (wr == 0) PG8_BAR; }
    PG8_BAR;
#undef PG8_SA
#undef PG8_SB
#undef PG8_STAGE
#undef PG8_LDA
#undef PG8_LDB
#undef PG8_MMA
#undef PG8_WAIT_V
#undef PG8_WAIT_L
#undef PG8_BAR
#undef PG8_SCHED
}
}

__device__ __forceinline__ float fsigmoid(float x) { return __builtin_amdgcn_rcpf(1.0f + __builtin_amdgcn_exp2f(-L2E * x)); }
__device__ __forceinline__ float bf_lo(unsigned w) { return __builtin_bit_cast(float, w << 16); }
__device__ __forceinline__ float bf_hi(unsigned w) { return __builtin_bit_cast(float, w & 0xffff0000u); }
__device__ __forceinline__ unsigned f2bf(float f) { unsigned u = __builtin_bit_cast(unsigned, f); return (u + 0x7fffu + ((u >> 16) & 1u)) >> 16; }
__device__ __forceinline__ unsigned pk2(float lo, float hi) { return f2bf(lo) | (f2bf(hi) << 16); }
using pg8::cvt_pk_bf16;

struct EpiP1 {
    static constexpr bool PERM = false, HAS_MID = false; static constexpr int MID_T = -2;
    bf16_t* PB; bf16_t* UV; bf16_t* XB; bf16_t* GR; bf16_t* GB; const float* bgate;
    __device__ __forceinline__ void mid(f32x4 (&)[2][2][4][2], const pg8::Unit&, int, int, int, int) const {}
    __device__ __forceinline__ void operator()(const f32x4 (&acc)[2][2][4][2], const pg8::Unit& u, int wr, int wc, int fr, int fq) const {
        int pm_ = u.pm; asm volatile("" : "+s"(pm_));
        const int type = u.pn & 1, ch = (u.pn >> 1) * 64 + wc * 16 + fq * 4;
        const int row0 = pm_ * 256 + wr * 64 + fr;
        if (type == 0) {
#pragma unroll
            for (int ai = 0; ai < 2; ++ai)
#pragma unroll
                for (int m = 0; m < 4; ++m) {
                    const size_t row = (size_t)(row0 + ai * 128 + m * 16);
                    const f32x4 vb = acc[ai][0][m][0], vc = acc[ai][0][m][1], vh = acc[ai][1][m][0], vz = acc[ai][1][m][1];
                    f32x4 p = vc * vh, q;
#pragma unroll
                    for (int j = 0; j < 4; ++j) q[j] = vb[j] * vz[j] * fsigmoid(vz[j]);
                    u32x2 wp, wq; wp.x = cvt_pk_bf16(p[0], p[1]); wp.y = cvt_pk_bf16(p[2], p[3]); wq.x = cvt_pk_bf16(q[0], q[1]); wq.y = cvt_pk_bf16(q[2], q[3]);
                    *(u32x2*)(PB + row * 1024 + ch) = wp;
                    *(u32x2*)(UV + row * 2048 + ch) = wq;
                }
        } else {
            const f32x4 bga = *(const f32x4*)(bgate + ch), bgb = *(const f32x4*)(bgate + 1024 + ch);
#pragma unroll
            for (int ai = 0; ai < 2; ++ai)
#pragma unroll
                for (int m = 0; m < 4; ++m) {
                    const size_t row = (size_t)(row0 + ai * 128 + m * 16);
                    const f32x4 vx = acc[ai][0][m][0], vz = acc[ai][0][m][1], va = acc[ai][1][m][0], vb = acc[ai][1][m][1];
                    f32x4 sz, gr, gb;
#pragma unroll
                    for (int j = 0; j < 4; ++j) {
                        sz[j] = vz[j] * fsigmoid(vz[j]);
                        const float ea = __builtin_amdgcn_exp2f(-L2E * (va[j] + bga[j]));
                        const float eb = __builtin_amdgcn_exp2f(-L2E * fmaxf(vb[j] + bgb[j], -60.f));
                        const float ga = __builtin_amdgcn_rcpf(1.0f + ea);
                        gb[j] = __builtin_amdgcn_rcpf(1.0f + eb);
                        gr[j] = ga * (1.0f + eb);
                    }
                    u32x2 w0, w1, w2, w3;
                    w0.x = cvt_pk_bf16(vx[0], vx[1]); w0.y = cvt_pk_bf16(vx[2], vx[3]);
                    w1.x = cvt_pk_bf16(sz[0], sz[1]); w1.y = cvt_pk_bf16(sz[2], sz[3]);
                    w2.x = cvt_pk_bf16(gr[0], gr[1]); w2.y = cvt_pk_bf16(gr[2], gr[3]);
                    w3.x = cvt_pk_bf16(gb[0], gb[1]); w3.y = cvt_pk_bf16(gb[2], gb[3]);
                    *(u32x2*)(XB + row * 1024 + ch) = w0;
                    *(u32x2*)(UV + row * 2048 + 1024 + ch) = w1;
                    *(u32x2*)(GR + row * 1024 + ch) = w2;
                    *(u32x2*)(GB + row * 1024 + ch) = w3;
                }
        }
    }
};

struct EpiP3 {
    static constexpr bool PERM = true, HAS_MID = true; static constexpr int MID_T = 16;
    const bf16_t* GR; const bf16_t* GB; bf16_t* MG;
    __device__ __forceinline__ void mid(f32x4 (&acc)[2][2][4][2], const pg8::Unit& u, int wr, int wc, int fr, int fq) const {
        int pm_ = u.pm; asm volatile("" : "+s"(pm_));
        const int row0 = pm_ * 256 + wr * 64 + fr, col0 = u.pn * 256 + wc * 32 + 8 * fq;
#pragma unroll
        for (int ai = 0; ai < 2; ++ai)
#pragma unroll
            for (int m = 0; m < 4; ++m) { const bf16_t* rp = GR + (size_t)(row0 + ai * 128 + m * 16) * 1024 + col0;
#pragma unroll
                for (int bj = 0; bj < 2; ++bj) { const u32x4 w = *(const u32x4*)(rp + bj * 128);
                    acc[ai][bj][m][0] *= (f32x4){bf_lo(w.x), bf_hi(w.x), bf_lo(w.y), bf_hi(w.y)};
                    acc[ai][bj][m][1] *= (f32x4){bf_lo(w.z), bf_hi(w.z), bf_lo(w.w), bf_hi(w.w)}; }
                asm volatile("" ::: "memory"); }
    }
    __device__ __forceinline__ void operator()(const f32x4 (&acc)[2][2][4][2], const pg8::Unit& u, int wr, int wc, int fr, int fq) const {
        int pm_ = u.pm; asm volatile("" : "+s"(pm_));
        const int row0 = pm_ * 256 + wr * 64 + fr, col0 = u.pn * 256 + wc * 32 + 8 * fq;
#pragma unroll
        for (int ai = 0; ai < 2; ++ai)
#pragma unroll
            for (int m = 0; m < 4; ++m) { const size_t off = (size_t)(row0 + ai * 128 + m * 16) * 1024 + col0;
#pragma unroll
                for (int bj = 0; bj < 2; ++bj) { const u32x4 w = *(const u32x4*)(GB + off + bj * 128);
                    const f32x4 v0 = acc[ai][bj][m][0] * (f32x4){bf_lo(w.x), bf_hi(w.x), bf_lo(w.y), bf_hi(w.y)};
                    const f32x4 v1 = acc[ai][bj][m][1] * (f32x4){bf_lo(w.z), bf_hi(w.z), bf_lo(w.w), bf_hi(w.w)};
                    u32x4 o; o.x = cvt_pk_bf16(v0[0], v0[1]); o.y = cvt_pk_bf16(v0[2], v0[3]); o.z = cvt_pk_bf16(v1[0], v1[1]); o.w = cvt_pk_bf16(v1[2], v1[3]);
                    *(u32x4*)(MG + off + bj * 128) = o; }
                asm volatile("" ::: "memory"); }
    }
};

struct EpiP4 {
    static constexpr bool PERM = true, HAS_MID = false; static constexpr int MID_T = -2;
    const float* X; float* OUT; float* RS;
    __device__ __forceinline__ void mid(f32x4 (&)[2][2][4][2], const pg8::Unit&, int, int, int, int) const {}
    __device__ __forceinline__ void operator()(const f32x4 (&acc)[2][2][4][2], const pg8::Unit& u, int wr, int wc, int fr, int fq) const {
        int pm_ = u.pm; asm volatile("" : "+s"(pm_));
        const int row0 = pm_ * 256 + wr * 64 + fr, col0 = u.pn * 256 + wc * 32 + 8 * fq;
#pragma unroll
        for (int ai = 0; ai < 2; ++ai)
#pragma unroll
            for (int m = 0; m < 4; ++m) { const int row = row0 + ai * 128 + m * 16; const size_t off = (size_t)row * 1024 + col0; float s = 0.f;
#pragma unroll
                for (int bj = 0; bj < 2; ++bj) {
                    const f32x4 x0 = *(const f32x4*)(X + off + bj * 128), x1 = *(const f32x4*)(X + off + bj * 128 + 4);
                    const f32x4 h0 = x0 + acc[ai][bj][m][0], h1 = x1 + acc[ai][bj][m][1];
                    s += (h0[0] * h0[0] + h0[1] * h0[1]) + (h0[2] * h0[2] + h0[3] * h0[3]) + (h1[0] * h1[0] + h1[1] * h1[1]) + (h1[2] * h1[2] + h1[3] * h1[3]);
                    *(f32x4*)(OUT + off + bj * 128) = h0; *(f32x4*)(OUT + off + bj * 128 + 4) = h1; }
                s += __shfl_xor(s, 16); s += __shfl_xor(s, 32);
                if (fq == 0) atomicAdd(RS + row, s);
                asm volatile("" ::: "memory"); }
    }
};

constexpr int RING_OFF = 0, RING_BYTES = 131072;
constexpr int LDSCTL_OFF = RING_BYTES, MISC_OFF = LDSCTL_OFF + 320;
constexpr int LDS_BYTES = 147456;
constexpr int NWAVES = 8;

typedef GAS unsigned gu32;
#define RLX_AGENT __ATOMIC_RELAXED, __HIP_MEMORY_SCOPE_AGENT
#define LDS_WAIT() asm volatile("s_waitcnt lgkmcnt(0)" ::: "memory")
#define VM_WAIT() asm volatile("s_waitcnt vmcnt(0)" ::: "memory")

#define XB_TMO      128
#define XB_XCNT(j)  (256  + 64 * (j))
#define XB_XSUB(j)  (1280 + 64 * (j))
#define XB_XGEN(j)  (2304 + 64 * (j))
#define XB_TOP      3328
#define XB_TOPGEN   3392
#define XCD_BAR_WORDS 3456
#define XB_SPIN_CAP (1u << 22)
constexpr int CW_BAR = 4096;

__device__ __forceinline__ unsigned xb_ld(unsigned* p)              { return __hip_atomic_load(p, __ATOMIC_RELAXED, __HIP_MEMORY_SCOPE_AGENT); }
__device__ __forceinline__ unsigned xb_add(unsigned* p, unsigned v) { return __hip_atomic_fetch_add(p, v, __ATOMIC_RELAXED, __HIP_MEMORY_SCOPE_AGENT); }
__device__ __forceinline__ unsigned xb_xcc_id() { return (unsigned)__builtin_amdgcn_s_getreg((3 << 11) | 20) & 0xFu; }
#define XB_SPIN(cond, bar) do { unsigned _sp = 0; while (cond) { __builtin_amdgcn_s_sleep(1); \
    if ((++_sp & 255u) == 0u) { if (xb_ld(&(bar)[XB_TMO])) break; if (_sp > XB_SPIN_CAP) { atomicAdd(&(bar)[XB_TMO], 1u); break; } } } } while (0)

struct XcdBarrier { unsigned* bar; unsigned x; volatile LAS unsigned* st; };

__device__ __forceinline__ XcdBarrier xcd_barrier_post(unsigned* bar, volatile LAS unsigned* st) {
    XcdBarrier b; b.bar = bar; b.x = xb_xcc_id(); b.st = st;
    if (threadIdx.x == 0) (void)xb_add(&bar[XB_XCNT(b.x)], 1u);
    return b;
}
__device__ __forceinline__ void xcd_barrier_complete(unsigned* bar, unsigned x, unsigned& nloc, unsigned& nx) {
    const unsigned G = gridDim.x * gridDim.y * gridDim.z;
    unsigned sum, cnt, mine, sp = 0u;
    for (;;) {
        sum = 0u; cnt = 0u; mine = 0u;
#pragma unroll
        for (unsigned j = 0; j < 16; ++j) { const unsigned c = xb_ld(&bar[XB_XCNT(j)]); sum += c; cnt += (c > 0u) ? 1u : 0u; mine = (j == x) ? c : mine; }
        if (sum == G) break;
        __builtin_amdgcn_s_sleep(1);
        if ((++sp & 255u) == 0u) { if (xb_ld(&bar[XB_TMO])) break; if (sp > XB_SPIN_CAP) { atomicAdd(&bar[XB_TMO], 1u); break; } }
    }
    nloc = mine > 0u ? mine : 1u; nx = cnt > 0u ? cnt : 1u;
}
__device__ __forceinline__ void xcd_barrier(const XcdBarrier& b) {
    asm volatile("s_waitcnt vmcnt(0)" ::: "memory");
    __syncthreads();
    if (threadIdx.x == 0) {
        unsigned* bar = b.bar;
        __builtin_amdgcn_s_waitcnt(0);
        unsigned nloc = b.st[0], nx = b.st[1];
        if (nloc == 0u) { xcd_barrier_complete(bar, b.x, nloc, nx); b.st[0] = nloc; b.st[1] = nx; }
        const unsigned old = xb_add(&bar[XB_XSUB(b.x)], 1u);
        const unsigned gen = old / nloc;
        if (old + 1u == (gen + 1u) * nloc) {
            __builtin_amdgcn_fence(__ATOMIC_RELEASE, "agent");
            asm volatile("s_waitcnt vmcnt(0)" ::: "memory");
            const unsigned og = xb_add(&bar[XB_TOP], 1u);
            const unsigned tg = og / nx;
            if (og + 1u == (tg + 1u) * nx) xb_add(&bar[XB_TOPGEN], 1u);
            else XB_SPIN(xb_ld(&bar[XB_TOPGEN]) == tg, bar);
            __builtin_amdgcn_fence(__ATOMIC_ACQUIRE, "agent");
            xb_add(&bar[XB_XGEN(b.x)], 1u);
            asm volatile("s_waitcnt vmcnt(0)" ::: "memory");
        } else {
            XB_SPIN(xb_ld(&bar[XB_XGEN(b.x)]) == gen, bar);
            __builtin_amdgcn_fence(__ATOMIC_ACQUIRE, "agent");
            asm volatile("s_waitcnt vmcnt(0)" ::: "memory");
        }
    }
    __syncthreads();
}

struct Frame {
    LAS unsigned char* lds;
    volatile LAS unsigned* MISC;
    gu32* ctl;
    int tid, lane, wave, vcu, G;
    const float *x, *meta, *norm_g, *w_in, *b_gate, *conv_a_w, *w_proj_a, *conv_b_w, *conv_b_b, *w_rg_a, *b_rg_a, *w_rg_i, *b_rg_i, *lru, *w_proj_b, *w_out, *fin_g;
    float* out; float* RS;
    bf16_t *WinT, *WabT, *WoutT, *WgaT, *WgiT;
    bf16_t *XN, *PB, *XB, *UV, *GR, *GB;
};

__device__ __forceinline__ float wave_sum(float v) {
#pragma unroll
    for (int o = 1; o < 64; o <<= 1) v += __shfl_xor(v, o);
    return v;
}

template <class FMap>
__device__ __forceinline__ void p0_transpose_item(const float* W, int Nsrc, bf16_t* WT, int ldo, int col_off, LAS float* scr, int kb, int nb, int lane, FMap fmap) {
    const int k0 = 64 * kb, n0 = 32 * nb;
    const int fsrc = fmap(n0 + (lane & 31));
#pragma unroll 8
    for (int i = 0; i < 32; ++i) { const int kk = 2 * i + (lane >> 5); scr[kk * 33 + (lane & 31)] = W[(size_t)(k0 + kk) * Nsrc + fsrc]; }
    LDS_WAIT(); asm volatile("" ::: "memory");
    const int c = lane & 7;
#pragma unroll
    for (int j = 0; j < 4; ++j) { const int n = (lane >> 3) + 8 * j; const LAS float* s = scr + (8 * c) * 33 + n;
        u32x4 o; o.x = pk2(s[0 * 33], s[1 * 33]); o.y = pk2(s[2 * 33], s[3 * 33]); o.z = pk2(s[4 * 33], s[5 * 33]); o.w = pk2(s[6 * 33], s[7 * 33]);
        *(GAS u32x4*)(WT + (size_t)(n0 + n) * ldo + col_off + k0 + 8 * c) = o; }
    LDS_WAIT(); asm volatile("" ::: "memory");
}
struct FIdent { __device__ __forceinline__ int operator()(int n) const { return n; } };
struct FWin {
    __device__ __forceinline__ int operator()(int np) const {
        const int pn = np >> 8, s = np & 255, type = pn & 1, cb = pn >> 1;
        const int bj = s >> 7, wc = (s >> 5) & 3, n = (s >> 4) & 1, fq = (s >> 2) & 3, j = s & 3;
        return (type * 4 + 2 * bj + n) * 1024 + cb * 64 + wc * 16 + fq * 4 + j;
    }
};

__device__ __forceinline__ void rms_row_to_bf16(const float* xrow, const float* g, bf16_t* orow, int lane) {
    const GAS f32x4* xr = (const GAS f32x4*)xrow + lane; const GAS f32x4* gr = (const GAS f32x4*)g + lane;
    f32x4 v[4]; float s = 0.f;
#pragma unroll
    for (int j = 0; j < 4; ++j) { v[j] = xr[64 * j]; s += (v[j].x * v[j].x + v[j].y * v[j].y) + (v[j].z * v[j].z + v[j].w * v[j].w); }
    const float rstd = 1.0f / sqrtf(wave_sum(s) * (1.f / D) + RMS_EPS);
    GAS u32x2* o8 = (GAS u32x2*)orow + lane;
#pragma unroll
    for (int j = 0; j < 4; ++j) { const f32x4 gg = gr[64 * j]; u32x2 w; w.x = pk2(v[j].x * rstd * gg.x, v[j].y * rstd * gg.y); w.y = pk2(v[j].z * rstd * gg.z, v[j].w * rstd * gg.w); o8[64 * j] = w; }
}

__device__ __forceinline__ void p0_prologue(Frame& F) {
    LAS float* scr = (LAS float*)(F.lds + RING_OFF + F.wave * 16384);
    const int gw = F.vcu * NWAVES + F.wave, NGW = F.G * NWAVES;
    constexpr int I_IN = 16 * 256, I_P = 16 * 32, I_G = 4 * 4 * 8;
    constexpr int NITEMS = I_IN + 3 * I_P + 2 * I_G;
    for (int it = gw; it < NITEMS; it += NGW) {
        int r = it;
        if (r < I_IN) { p0_transpose_item(F.w_in, NIN, F.WinT, 1024, 0, scr, r / 256, r % 256, F.lane, FWin()); continue; } r -= I_IN;
        if (r < I_P) { p0_transpose_item(F.w_proj_a, 1024, F.WabT, 2048, 0, scr, r / 32, r % 32, F.lane, FIdent()); continue; } r -= I_P;
        if (r < I_P) { p0_transpose_item(F.w_proj_b, 1024, F.WabT, 2048, 1024, scr, r / 32, r % 32, F.lane, FIdent()); continue; } r -= I_P;
        if (r < I_P) { p0_transpose_item(F.w_out, 1024, F.WoutT, 1024, 0, scr, r / 32, r % 32, F.lane, FIdent()); continue; } r -= I_P;
        if (r < I_G) { const int h = r / 32, q = r % 32; p0_transpose_item(F.w_rg_a + (size_t)h * 65536, 256, F.WgaT + (size_t)h * 65536, 256, 0, scr, q / 8, q % 8, F.lane, FIdent()); continue; } r -= I_G;
        { const int h = r / 32, q = r % 32; p0_transpose_item(F.w_rg_i + (size_t)h * 65536, 256, F.WgiT + (size_t)h * 65536, 256, 0, scr, q / 8, q % 8, F.lane, FIdent()); }
    }
    for (int m = gw; m < MP; m += NGW) {
        bf16_t* orow = F.XN + (size_t)m * D;
        if (m < MR) rms_row_to_bf16(F.x + (size_t)m * D, F.norm_g, orow, F.lane);
        else if (m < MR + NMETA) rms_row_to_bf16(F.meta + (size_t)(m - MR) * D, F.norm_g, orow, F.lane);
        else { GAS u32x4* o = (GAS u32x4*)orow + F.lane; o[0] = (u32x4){0u, 0u, 0u, 0u}; o[64] = (u32x4){0u, 0u, 0u, 0u}; }
    }
}

__device__ __forceinline__ int prev_row(int row, int k) {
    if (row >= MR) { const int m = row - MR; return m >= k ? row - k : -1; }
    const int s = row & (SEQ - 1); return s >= k ? row - k : MR + NMETA + (s - k);
}
__device__ __forceinline__ void unpack8(const u32x4 w, float (&f)[8]) { f[0] = bf_lo(w.x); f[1] = bf_hi(w.x); f[2] = bf_lo(w.y); f[3] = bf_hi(w.y); f[4] = bf_lo(w.z); f[5] = bf_hi(w.z); f[6] = bf_lo(w.w); f[7] = bf_hi(w.w); }
__device__ __forceinline__ void p1b_conv(Frame& F) {
    const int gt = F.vcu * (NWAVES * 64) + F.tid, NT = F.G * NWAVES * 64;
    constexpr int NITEMS = (MR + NMETA) * 128;
    bf16_t* XC = F.XN;
    for (int it = gt; it < NITEMS; it += NT) {
        const int row = it >> 7, ch = (it & 127) * 8;
        const int r1 = prev_row(row, 1), r2 = prev_row(row, 2), r3 = prev_row(row, 3);
        const u32x4 z4 = (u32x4){0u, 0u, 0u, 0u};
        const u32x4 p0 = *(const GAS u32x4*)(F.PB + (size_t)row * 1024 + ch);
        const u32x4 p1 = r1 >= 0 ? *(const GAS u32x4*)(F.PB + (size_t)r1 * 1024 + ch) : z4;
        const u32x4 p2 = r2 >= 0 ? *(const GAS u32x4*)(F.PB + (size_t)r2 * 1024 + ch) : z4;
        const u32x4 qq = *(const GAS u32x4*)(F.UV + (size_t)row * 2048 + ch);
        const u32x4 x0 = *(const GAS u32x4*)(F.XB + (size_t)row * 1024 + ch);
        const u32x4 x1 = r1 >= 0 ? *(const GAS u32x4*)(F.XB + (size_t)r1 * 1024 + ch) : z4;
        const u32x4 x2 = r2 >= 0 ? *(const GAS u32x4*)(F.XB + (size_t)r2 * 1024 + ch) : z4;
        const u32x4 x3 = r3 >= 0 ? *(const GAS u32x4*)(F.XB + (size_t)r3 * 1024 + ch) : z4;
        float fp0[8], fp1[8], fp2[8], fq[8], fx0[8], fx1[8], fx2[8], fx3[8];
        unpack8(p0, fp0); unpack8(p1, fp1); unpack8(p2, fp2); unpack8(qq, fq); unpack8(x0, fx0); unpack8(x1, fx1); unpack8(x2, fx2); unpack8(x3, fx3);
        float ua[8], xc[8];
#pragma unroll
        for (int j = 0; j < 8; ++j) {
            const int c = ch + j;
            const float wa0 = F.conv_a_w[c], wa1 = F.conv_a_w[1024 + c], wa2 = F.conv_a_w[2048 + c];
            const float wb0 = F.conv_b_w[c], wb1 = F.conv_b_w[1024 + c], wb2 = F.conv_b_w[2048 + c], wb3 = F.conv_b_w[3072 + c];
            float ca = fp2[j] * wa0; ca = ca + fp1[j] * wa1; ca = ca + fp0[j] * wa2;
            ua[j] = fq[j] * ca;
            float cb = fx3[j] * wb0; cb = cb + fx2[j] * wb1; cb = cb + fx1[j] * wb2; cb = cb + fx0[j] * wb3;
            xc[j] = cb + F.conv_b_b[c];
        }
        u32x4 o1, o2;
        o1.x = pk2(ua[0], ua[1]); o1.y = pk2(ua[2], ua[3]); o1.z = pk2(ua[4], ua[5]); o1.w = pk2(ua[6], ua[7]);
        o2.x = pk2(xc[0], xc[1]); o2.y = pk2(xc[2], xc[3]); o2.z = pk2(xc[4], xc[5]); o2.w = pk2(xc[6], xc[7]);
        *(GAS u32x4*)(F.UV + (size_t)row * 2048 + ch) = o1;
        *(GAS u32x4*)(XC + (size_t)row * 1024 + ch) = o2;
    }
}

constexpr int P2_W_BYTES = 65536, P2_AGG_OFF = 65536;

__device__ __forceinline__ int tok_of(int rho, int hh) { return (rho & 3) + 8 * (rho >> 2) + 4 * hh; }

template <bool META>
__device__ __forceinline__ void p2_slab(LAS const unsigned char* wl, const bf16_t* XC, int R0, int kbase, int chb, int lane,
                                        const float (&ba)[2], const float (&bi)[2], const float (&nsp)[2],
                                        float (&cumA)[2][16], float (&hloc)[2][16]) {
    const int c = lane & 31, hh = lane >> 5;
    const int rowA = META ? MR + (c & 15) : R0 + c;
    const int rowbase = META ? MR - 16 : R0;
    const GAS bf16x8* ap = (const GAS bf16x8*)(XC + (size_t)rowA * 1024 + kbase + 8 * hh);
    f32x16 acc[4];
#pragma unroll
    for (int s = 0; s < 4; ++s)
#pragma unroll
        for (int r = 0; r < 16; ++r) acc[s][r] = 0.f;
    const unsigned rowoff = (unsigned)c * 512u; const int x15 = lane & 15;
#pragma unroll
    for (int kh = 0; kh < 2; ++kh) {
        bf16x8 af[8];
#pragma unroll
        for (int k8 = 0; k8 < 8; ++k8) af[k8] = ap[2 * (8 * kh + k8)];
#pragma unroll
        for (int k8 = 0; k8 < 8; ++k8) { const int ks = 8 * kh + k8;
            const unsigned boff = rowoff + ((unsigned)((2 * ks + hh) ^ x15) << 4);
#pragma unroll
            for (int s = 0; s < 4; ++s) { const bf16x8 b = *(const LAS bf16x8*)(wl + boff + s * 16384);
                acc[s] = __builtin_amdgcn_mfma_f32_32x32x16_bf16(af[k8], b, acc[s], 0, 0, 0); }
        }
        asm volatile("" ::: "memory");
    }
    unsigned xcv[16];
#pragma unroll
    for (int rho = 0; rho < 16; ++rho) { if (META && rho < 8) { xcv[rho] = 0u; continue; }
        xcv[rho] = *(const GAS unsigned*)(XC + (size_t)(rowbase + tok_of(rho, hh)) * 1024 + chb + 2 * c); }
#pragma unroll
    for (int s2 = 0; s2 < 2; ++s2)
#pragma unroll
        for (int rho = 0; rho < 16; ++rho) {
            if (META && rho < 8) { cumA[s2][rho] = 1.f; hloc[s2][rho] = 0.f; continue; }
            const float r = fsigmoid(acc[s2][rho] + ba[s2]);
            const float ig = fsigmoid(acc[2 + s2][rho] + bi[s2]);
            const float la = nsp[s2] * r;
            const float a = __builtin_amdgcn_exp2f(la * L2E);
            const float y = 2.f * la;
            const float om_ser = -y * (1.f + y * (0.5f + y * (0.16666667f + y * 0.041666667f)));
            const float om = (y > -0.05f) ? om_ser : (1.f - a * a);
            float mult = __builtin_amdgcn_sqrtf(om);
            if (META && rho == 8) mult = (hh == 0) ? 1.f : mult;
            const float xc = s2 ? bf_hi(xcv[rho]) : bf_lo(xcv[rho]);
            cumA[s2][rho] = a; hloc[s2][rho] = xc * ig * mult;
        }
#pragma unroll
    for (int s2 = 0; s2 < 2; ++s2)
#pragma unroll
        for (int g = 0; g < 4; ++g) { const int b = 4 * g;
            hloc[s2][b + 1] = cumA[s2][b + 1] * hloc[s2][b] + hloc[s2][b + 1];
            hloc[s2][b + 2] = cumA[s2][b + 2] * hloc[s2][b + 1] + hloc[s2][b + 2];
            hloc[s2][b + 3] = cumA[s2][b + 3] * hloc[s2][b + 2] + hloc[s2][b + 3];
            cumA[s2][b + 1] *= cumA[s2][b]; cumA[s2][b + 2] *= cumA[s2][b + 1]; cumA[s2][b + 3] *= cumA[s2][b + 2]; }
}

__device__ __forceinline__ void p2_group_prefix(const float (&cumA)[2][16], const float (&hloc)[2][16], int hh, float (&exP)[2][4], float (&exS)[2][4], float (&slP)[2], float (&slS)[2]) {
#pragma unroll
    for (int s2 = 0; s2 < 2; ++s2) {
        float runP = 1.f, runS = 0.f;
#pragma unroll
        for (int g = 0; g < 4; ++g) {
            const auto pp = __builtin_amdgcn_permlane32_swap(__float_as_uint(cumA[s2][4 * g + 3]), __float_as_uint(cumA[s2][4 * g + 3]), false, false);
            const auto ss = __builtin_amdgcn_permlane32_swap(__float_as_uint(hloc[s2][4 * g + 3]), __float_as_uint(hloc[s2][4 * g + 3]), false, false);
            const float Pe = __uint_as_float(pp[0]), Po = __uint_as_float(pp[1]), Se = __uint_as_float(ss[0]), So = __uint_as_float(ss[1]);
            const float ePe = runP, eSe = runS; runS = Pe * runS + Se; runP = Pe * runP;
            const float ePo = runP, eSo = runS; runS = Po * runS + So; runP = Po * runP;
            exP[s2][g] = hh ? ePo : ePe; exS[s2][g] = hh ? eSo : eSe;
        }
        slP[s2] = runP; slS[s2] = runS;
    }
}

__device__ __forceinline__ void p2_scan(Frame& F) {
    LAS unsigned char* wl = F.lds + RING_OFF;
    LAS float* agg = (LAS float*)(F.lds + RING_OFF + P2_AGG_OFF);
    const bf16_t* XC = F.XN;
    const int lane = F.lane, c = lane & 31, hh = lane >> 5, w = F.wave;
    for (int chain = F.vcu; chain < NBATCH * 16; chain += F.G) {
        const int cg = chain & 3, head = (chain >> 2) & 3, b = chain >> 4;
        const int kbase = head * 256, chb = head * 256 + cg * 64;
        __syncthreads();
        for (int idx = F.tid; idx < 128 * 32; idx += NWAVES * 64) {
            const int n = idx >> 5, q = idx & 31, s = n >> 5, cc = n & 31;
            const int chl = 2 * cc + (s & 1);
            const bf16_t* src = ((s < 2) ? F.WgaT : F.WgiT) + (size_t)head * 65536 + (size_t)(cg * 64 + chl) * 256 + q * 8;
            *(LAS u32x4*)(wl + n * 512 + ((q ^ (n & 15)) << 4)) = *(const GAS u32x4*)src;
        }
        float ba[2], bi[2], nsp[2];
#pragma unroll
        for (int s2 = 0; s2 < 2; ++s2) { const int ch = chb + 2 * c + s2; ba[s2] = F.b_rg_a[ch]; bi[s2] = F.b_rg_i[ch]; nsp[s2] = -8.0f * log1pf(expf(-F.lru[ch])); }
        LDS_WAIT();
        __syncthreads();
        float carry[2];
        float cumA[2][16], hloc[2][16], exP[2][4], exS[2][4], slP[2], slS[2];
        p2_slab<true>(wl, XC, 0, kbase, chb, lane, ba, bi, nsp, cumA, hloc);
        p2_group_prefix(cumA, hloc, hh, exP, exS, slP, slS);
        carry[0] = slS[0]; carry[1] = slS[1];
        for (int j = 0; j < SEQ / 256; ++j) {
            const int R0 = b * SEQ + j * 256 + w * 32;
            p2_slab<false>(wl, XC, R0, kbase, chb, lane, ba, bi, nsp, cumA, hloc);
            unsigned szv[16];
#pragma unroll
            for (int rho = 0; rho < 16; ++rho) szv[rho] = *(const GAS unsigned*)(F.UV + (size_t)(R0 + tok_of(rho, hh)) * 2048 + 1024 + chb + 2 * c);
            p2_group_prefix(cumA, hloc, hh, exP, exS, slP, slS);
            LAS float* ag = agg + (j & 1) * 1024;
            if (hh == 0) *(LAS f32x4*)(ag + w * 128 + c * 4) = (f32x4){slP[0], slS[0], slP[1], slS[1]};
            LDS_WAIT();
            __syncthreads();
            float cs[2] = {carry[0], carry[1]}, run[2] = {carry[0], carry[1]};
#pragma unroll
            for (int ww = 0; ww < 8; ++ww) { const f32x4 e = *(const LAS f32x4*)(ag + ww * 128 + c * 4);
                if (ww == w) { cs[0] = run[0]; cs[1] = run[1]; }
                run[0] = e[0] * run[0] + e[1]; run[1] = e[2] * run[1] + e[3]; }
            carry[0] = run[0]; carry[1] = run[1];
#pragma unroll
            for (int g = 0; g < 4; ++g) {
                const float cg0 = exP[0][g] * cs[0] + exS[0][g], cg1 = exP[1][g] * cs[1] + exS[1][g];
#pragma unroll
                for (int t = 0; t < 4; ++t) { const int rho = 4 * g + t;
                    const float h0 = hloc[0][rho] + cumA[0][rho] * cg0, h1 = hloc[1][rho] + cumA[1][rho] * cg1;
                    const unsigned o = cvt_pk_bf16(h0 * bf_lo(szv[rho]), h1 * bf_hi(szv[rho]));
                    *(GAS unsigned*)(F.UV + (size_t)(R0 + tok_of(rho, hh)) * 2048 + 1024 + chb + 2 * c) = o; }
            }
        }
    }
    __syncthreads();
}

__device__ __forceinline__ void p5_final(Frame& F) {
    const int gw = F.vcu * NWAVES + F.wave, NGW = F.G * NWAVES;
    for (int m = gw; m < MR; m += NGW) {
        const float rstd = 1.0f / sqrtf(F.RS[m] * (1.f / D) + RMS_EPS);
        GAS f32x4* o = (GAS f32x4*)(F.out + (size_t)m * D) + F.lane; const GAS f32x4* gr = (const GAS f32x4*)F.fin_g + F.lane;
#pragma unroll
        for (int j = 0; j < 4; ++j) { const f32x4 v = o[64 * j], gg = gr[64 * j]; o[64 * j] = v * rstd * gg; }
    }
}

constexpr int PER_PHASE = 7;
constexpr int N_LAUNCHES = MK_N_LAUNCHES;
struct Args { const float* in[17]; float* out; unsigned char* ws; int ph_lo, ph_hi, li, pad; };

__global__ void __launch_bounds__(NWAVES * 64, 2) hybrid_fwd(Args args) {
    extern __shared__ __attribute__((aligned(16))) unsigned char lds[];
    Frame F;
    F.lds = (LAS unsigned char*)lds;
    F.MISC = (volatile LAS unsigned*)(F.lds + MISC_OFF);
    F.tid = threadIdx.x; F.lane = F.tid & 63; F.wave = __builtin_amdgcn_readfirstlane(F.tid >> 6);
    F.G = gridDim.x; { const int bx = blockIdx.x; F.vcu = (F.G % 8 == 0) ? (bx % 8) * (F.G / 8) + bx / 8 : bx; }
    unsigned char* ws = args.ws;
    F.ctl = (gu32*)(ws + WS_CTL);
    F.x = args.in[0]; F.meta = args.in[1]; F.norm_g = args.in[2]; F.w_in = args.in[3]; F.b_gate = args.in[4]; F.conv_a_w = args.in[5]; F.w_proj_a = args.in[6];
    F.conv_b_w = args.in[7]; F.conv_b_b = args.in[8]; F.w_rg_a = args.in[9]; F.b_rg_a = args.in[10]; F.w_rg_i = args.in[11]; F.b_rg_i = args.in[12]; F.lru = args.in[13];
    F.w_proj_b = args.in[14]; F.w_out = args.in[15]; F.fin_g = args.in[16];
    F.out = args.out; F.RS = (float*)(ws + WS_RS);
    F.WinT = (bf16_t*)(ws + WS_WIN); F.WabT = (bf16_t*)(ws + WS_WAB); F.WoutT = (bf16_t*)(ws + WS_WOUT); F.WgaT = (bf16_t*)(ws + WS_WGA); F.WgiT = (bf16_t*)(ws + WS_WGI);
    F.XN = (bf16_t*)(ws + WS_XN); F.PB = (bf16_t*)(ws + WS_PB); F.XB = (bf16_t*)(ws + WS_XB); F.UV = (bf16_t*)(ws + WS_UV); F.GR = (bf16_t*)(ws + WS_GR); F.GB = (bf16_t*)(ws + WS_GB);
    for (int u = F.tid; u < (LDS_BYTES - LDSCTL_OFF) / 4; u += NWAVES * 64) ((LAS unsigned*)(F.lds + LDSCTL_OFF))[u] = 0u;
    __syncthreads();
    XcdBarrier bar; bar.bar = (unsigned*)(F.ctl + CW_BAR); bar.x = 0; bar.st = nullptr;
    if (N_LAUNCHES != PER_PHASE) bar = xcd_barrier_post((unsigned*)(F.ctl + CW_BAR), F.MISC + 8);
#define GRID_BAR() do { if (N_LAUNCHES != PER_PHASE) xcd_barrier(bar); } while (0)
    const int lo = args.ph_lo, hi = args.ph_hi;
#define IN(k) (lo <= (k) && (k) < hi)
#define BOTH(k) (IN(k) && IN((k) + 1))

    if (IN(0)) { p0_prologue(F); if (BOTH(0)) GRID_BAR(); }

    if (IN(1)) {
        pg8::Gemm g{F.XN, F.WinT, 1024, 1024, 1024}; pg8::StaticOrder S; S.init(MP / 256, NIN / 256, F.G, (int)blockIdx.x);
        EpiP1 E{F.PB, F.UV, F.XB, F.GR, F.GB, F.b_gate};
        pg8::gemm_phase<EpiP1, pg8::StaticOrder, true, true>(F.lds + RING_OFF, g, S, E);
        if (BOTH(1)) GRID_BAR();
    }

    if (IN(2)) { p1b_conv(F); if (BOTH(2)) GRID_BAR(); }

    if (IN(3)) { p2_scan(F); if (BOTH(3)) GRID_BAR(); }

    if (IN(4)) {
        pg8::Gemm g{F.UV, F.WabT, 2048, 2048, 2048}; pg8::StaticOrder S; S.init(MR / 256, 4, F.G, (int)blockIdx.x);
        EpiP3 E{F.GR, F.GB, F.PB};
        pg8::gemm_phase<EpiP3, pg8::StaticOrder, true, true>(F.lds + RING_OFF, g, S, E);
        if (BOTH(4)) GRID_BAR();
    }

    if (IN(5)) {
        pg8::Gemm g{F.PB, F.WoutT, 1024, 1024, 1024}; pg8::StaticOrder S; S.init(MR / 256, 4, F.G, (int)blockIdx.x);
        EpiP4 E{F.x, F.out, F.RS};
        pg8::gemm_phase<EpiP4, pg8::StaticOrder, true, true>(F.lds + RING_OFF, g, S, E);
        if (BOTH(5)) GRID_BAR();
    }

    if (IN(6)) { p5_final(F); }
#undef IN
#undef BOTH
#undef GRID_BAR
}

extern "C" void kernel_launch(void* const* d_in, const int* in_sizes, int n_in, void* d_out, int out_size, void* d_ws, size_t ws_size, hipStream_t stream) {
    static int grid = 0;
    if (grid == 0) {
        if (n_in != 17 || in_sizes[0] != MR * D || out_size != MR * D || ws_size < WS_END) {
            fprintf(stderr, "kernel_launch: unexpected shapes: n_in %d in0 %d out %d ws %zu (need %zu)\n", n_in, n_in > 0 ? in_sizes[0] : -1, out_size, ws_size, (size_t)WS_END); grid = -1; return; }
        int dev = 0, cus = 0, per_cu = 0;
        if (hipGetDevice(&dev) != hipSuccess || hipDeviceGetAttribute(&cus, hipDeviceAttributeMultiprocessorCount, dev) != hipSuccess) { fprintf(stderr, "kernel_launch: device query failed\n"); grid = -1; return; }
        if (hipFuncSetAttribute((const void*)hybrid_fwd, hipFuncAttributeMaxDynamicSharedMemorySize, LDS_BYTES) != hipSuccess) { fprintf(stderr, "kernel_launch: hipFuncSetAttribute failed\n"); grid = -1; return; }
        if (hipOccupancyMaxActiveBlocksPerMultiprocessor(&per_cu, (const void*)hybrid_fwd, NWAVES * 64, LDS_BYTES) != hipSuccess || per_cu < 1) {
            fprintf(stderr, "kernel_launch: occupancy query reports %d blocks per CU\n", per_cu); (void)hipGetLastError(); grid = -1; return; }
        (void)hipGetLastError();
        grid = cus;
    }
    if (grid < 0) return;
    if (hipMemsetAsync((char*)d_ws + WS_CTL, 0, CTL_ZERO_BYTES, stream) != hipSuccess) { fprintf(stderr, "kernel_launch: memset failed\n"); return; }
    Args a{};
    for (int i = 0; i < 17; ++i) a.in[i] = (const float*)d_in[i];
    a.out = (float*)d_out; a.ws = (unsigned char*)d_ws;
    for (int li = 0; li < N_LAUNCHES; ++li) {
        a.ph_lo = (N_LAUNCHES == PER_PHASE) ? li : 0; a.ph_hi = (N_LAUNCHES == PER_PHASE) ? li + 1 : PER_PHASE; a.li = li;
        hipLaunchKernelGGL(hybrid_fwd, dim3(grid), dim3(NWAVES * 64), LDS_BYTES, stream, a);
        const hipError_t le = hipPeekAtLastError();
        if (le != hipSuccess) { fprintf(stderr, "kernel_launch: launch %d failed: %s\n", li, hipGetErrorName(le)); break; }
    }
}
```

```cpp
#include <hip/hip_runtime.h>
#include <cstdio>
#include <cstdint>

#ifndef MK_N_LAUNCHES
#define MK_N_LAUNCHES 1
#endif

#define LAS __attribute__((address_space(3)))
#define GAS __attribute__((address_space(1)))
typedef unsigned short bf16_t;
typedef short bf16x8 __attribute__((ext_vector_type(8)));
typedef float f32x4 __attribute__((ext_vector_type(4)));
typedef float f32x16 __attribute__((ext_vector_type(16)));
typedef unsigned u32x4 __attribute__((ext_vector_type(4)));
typedef unsigned u32x2 __attribute__((ext_vector_type(2)));

constexpr int D = 1024, NBATCH = 16, SEQ = 4096, NMETA = 16, NIN = 8192;
constexpr int MR = NBATCH * SEQ;
constexpr int MP = MR + 256;
constexpr float RMS_EPS = 1e-6f;
constexpr float L2E = 1.4426950408889634f;

constexpr size_t MiB = 1u << 20;
constexpr size_t WS_CTL = 0, CTL_ZERO_BYTES = 1 * MiB;
constexpr size_t WS_RS = 512 * 1024;
constexpr size_t WS_WIN = 2 * MiB;
constexpr size_t WS_WAB = 18 * MiB;
constexpr size_t WS_WOUT = 22 * MiB;
constexpr size_t WS_WGA = 24 * MiB;
constexpr size_t WS_WGI = WS_WGA + 512 * 1024;
constexpr size_t ACT = 129 * MiB;
constexpr size_t WS_XN = 32 * MiB;
constexpr size_t WS_XC = WS_XN + ACT;
constexpr size_t WS_SIDE = WS_XC + ACT;
constexpr size_t WS_SA = WS_SIDE;
constexpr size_t WS_SB = WS_SIDE + 16 * MiB;
constexpr size_t WS_UV = WS_SIDE + ACT;
constexpr size_t WS_GR = WS_UV + 2 * ACT;
constexpr size_t WS_GB = WS_GR + ACT;
constexpr size_t WS_END = WS_GB + ACT;
static_assert((size_t)514 * 6 * 1024 * 4 <= 16 * MiB, "side buffers");
static_assert((size_t)MP * 1024 * 2 <= ACT, "activation slot");
static_assert(WS_END <= 1024 * MiB, "workspace");

namespace pg8 {
constexpr int BM = 256, BK = 64, HALF = 128, HTB = HALF * BK * 2, STAGE_BYTES = 8 * HTB, NXCD = 8, WGM = 8;

__host__ __device__ __forceinline__ int lds_byte(int r, int c) { const int st = (r >> 4) * 2 + (c >> 5), rr = r & 15, cc = c & 31, ob = rr * 64 + cc * 2; return st * 1024 + (ob ^ (((ob >> 9) & 1) << 5)); }
__host__ __device__ __forceinline__ void stage_rc(int b, int& R, int& C) { const int st = b / 1024, sb = b % 1024, swz = sb ^ (((sb >> 9) & 1) << 5); R = (st >> 1) * 16 + swz / 64; C = (st & 1) * 32 + (swz % 64) / 2; }
__host__ __device__ __forceinline__ int perm32(int rho) { const int n = rho >> 4, i = rho & 15; return 8 * (i >> 2) + 4 * n + (i & 3); }

struct Unit { int pm, pn; };
struct Gemm { const bf16_t* A; const bf16_t* Bt; int lda, ldb, K; };

struct StaticOrder {
    int nM, nN, nwg, G, c;
    __host__ __device__ void init(int nM_, int nN_, int G_, int c_) { nM = nM_; nN = nN_; nwg = nM * nN; G = G_; c = c_; }
    __host__ __device__ bool next(int i, Unit& u) const {
        const long L = (long)i * G + c; if (L >= nwg) return false;
        int wgid = (int)L; { const int q = nwg / NXCD, r = nwg % NXCD, xcd = wgid % NXCD, off = wgid / NXCD; wgid = (xcd < r ? xcd * (q + 1) : r * (q + 1) + (xcd - r) * q) + off; }
        const int nig = WGM * nN, gid = wgid / nig, fm = gid * WGM, gsz = (nM - fm) < WGM ? (nM - fm) : WGM;
        u.pm = fm + ((wgid % nig) % gsz); u.pn = (wgid % nig) / gsz; return true;
    }
    __device__ __forceinline__ void a_ready(const Unit&) const {}
    __device__ __forceinline__ void done(const Unit&) const {}
};

typedef float f32x2_t __attribute__((ext_vector_type(2)));
typedef __bf16 bf16x2_t __attribute__((ext_vector_type(2)));
__device__ __forceinline__ unsigned cvt_pk_bf16(float lo, float hi) { const f32x2_t v = {lo, hi}; const bf16x2_t r = __builtin_convertvector(v, bf16x2_t); return __builtin_bit_cast(unsigned, r); }

template <class Epi, class Sched, bool ALIGN_EPI = false, bool SP2 = false>
__device__ __forceinline__ void gemm_phase(LAS unsigned char* lds, const Gemm g, const Sched& S, const Epi& E) {
    const int tid = threadIdx.x, wid = __builtin_amdgcn_readfirstlane(tid >> 6), lane = tid & 63, wr = wid >> 2, wc = wid & 3, fr = lane & 15, fq = lane >> 4;
    const int K = g.K, nt = K / BK;
    unsigned voffA[2], voffB[2];
#pragma unroll
    for (int i = 0; i < 2; ++i) { int R, C; stage_rc(tid * 16 + i * 8192, R, C); const int Rb = Epi::PERM ? ((R & ~31) + perm32(R & 31)) : R;
        const int Ra = Epi::ROWPERM ? (128 * (R >> 6) + 8 * (R & 15) + ((R >> 4) & 3)) : R;
        voffA[i] = (unsigned)(Ra * g.lda + C) * 2u; voffB[i] = (unsigned)(Rb * g.ldb + C) * 2u; }
    const size_t kstep = (size_t)(BK * 2);
    const size_t hstepA = Epi::ROWPERM ? (size_t)4 * g.lda * 2 : (size_t)HALF * g.lda * 2, hstepB = (size_t)HALF * g.ldb * 2;
    const size_t tstepA = (size_t)BM * g.lda * 2, tstepB = 2 * hstepB;
    const unsigned ldsw = (unsigned)wid * 1024u;
    const int aoff = lds_byte(wr * 64 + fr, fq * 8), boff = lds_byte(wc * 32 + fr, fq * 8);
#define PG8_SA(b, h) (((b) * 2 + (h)) * HTB)
#define PG8_SB(b, h) ((4 + (b) * 2 + (h)) * HTB)
#define PG8_STAGE(bufoff, gbase, voff) do { _Pragma("unroll") for (int _i = 0; _i < 2; ++_i) \
        __builtin_amdgcn_global_load_lds((const unsigned*)((const char*)(gbase) + (voff)[_i]), (LAS unsigned*)(lds + (bufoff) + ldsw + _i * 8192), 16, 0, 0); } while (0)
#define PG8_LDA(dst, b, h) do { _Pragma("unroll") for (int m = 0; m < 4; ++m) _Pragma("unroll") for (int k = 0; k < 2; ++k) dst[m][k] = *(const LAS bf16x8*)(lds + PG8_SA(b, h) + aoff + m * 2048 + k * 1024); } while (0)
#define PG8_LDB(dst, b, h) do { _Pragma("unroll") for (int n = 0; n < 2; ++n) _Pragma("unroll") for (int k = 0; k < 2; ++k) dst[n][k] = *(const LAS bf16x8*)(lds + PG8_SB(b, h) + boff + n * 2048 + k * 1024); } while (0)
#define PG8_MMA(ai, bj, At, Bt) do { __builtin_amdgcn_s_setprio(1); _Pragma("unroll") for (int m = 0; m < 4; ++m) _Pragma("unroll") for (int n = 0; n < 2; ++n) _Pragma("unroll") for (int k = 0; k < 2; ++k) \
        acc[ai][bj][m][n] = __builtin_amdgcn_mfma_f32_16x16x32_bf16(Bt[n][k], At[m][k], acc[ai][bj][m][n], 0, 0, 0); __builtin_amdgcn_s_setprio(0); } while (0)
#define PG8_WAIT_V(n) asm volatile("s_waitcnt vmcnt(" #n ")" ::: "memory")
#define PG8_WAIT_L(n) asm volatile("s_waitcnt lgkmcnt(" #n ")" ::: "memory")
#define PG8_BAR __builtin_amdgcn_s_barrier()
#define PG8_SCHED __builtin_amdgcn_sched_barrier(0)
    Unit cur, nxt; int ui = 0;
    if (!S.next(0, cur)) return;
    f32x4 acc[2][2][4][2];
    E.init(acc, cur, wr, wc, fr, fq);
    bf16x8 At[4][2], B0[2][2], B1[2][2];
    const char* cA = (const char*)g.A + (size_t)cur.pm * tstepA; const char* cB = (const char*)g.Bt + (size_t)cur.pn * tstepB;
    S.a_ready(cur);
    if constexpr (SP2) {
        PG8_STAGE(PG8_SB(0, 0), cB, voffB); PG8_STAGE(PG8_SB(0, 1), cB + hstepB, voffB); PG8_STAGE(PG8_SA(0, 0), cA, voffA); PG8_STAGE(PG8_SA(0, 1), cA + hstepA, voffA);
        if (wr == 1) PG8_BAR;
        PG8_WAIT_V(2); PG8_BAR;
        PG8_STAGE(PG8_SB(1, 0), cB + kstep, voffB); PG8_STAGE(PG8_SA(1, 0), cA + kstep, voffA); PG8_STAGE(PG8_SB(1, 1), cB + hstepB + kstep, voffB);
        PG8_WAIT_V(6); PG8_BAR;
    } else {
        PG8_STAGE(PG8_SB(0, 0), cB, voffB); PG8_STAGE(PG8_SA(0, 0), cA, voffA); PG8_STAGE(PG8_SB(0, 1), cB + hstepB, voffB); PG8_STAGE(PG8_SA(0, 1), cA + hstepA, voffA);
        if (wr == 1) PG8_BAR;
        PG8_WAIT_V(4); PG8_BAR;
        PG8_STAGE(PG8_SB(1, 0), cB + kstep, voffB); PG8_STAGE(PG8_SA(1, 0), cA + kstep, voffA); PG8_STAGE(PG8_SB(1, 1), cB + hstepB + kstep, voffB);
        PG8_WAIT_V(6); PG8_BAR;
    }
    for (;;) {
        const bool has_next = S.next(ui + 1, nxt);
        const char* nA = has_next ? (const char*)g.A + (size_t)nxt.pm * tstepA : cA; const char* nB = has_next ? (const char*)g.Bt + (size_t)nxt.pn * tstepB : cB;
        for (int t = 0; t < nt; t += 2) {
            const bool last = (t == nt - 2);
            const char* a1 = cA + (size_t)(t + 1) * kstep;
            const char* a2 = last ? nA : cA + (size_t)(t + 2) * kstep; const char* b2 = last ? nB : cB + (size_t)(t + 2) * kstep;
            const char* a3 = a2 + kstep; const char* b3 = b2 + kstep;
            if constexpr (Epi::HAS_MID) { if (t == Epi::MID_T) E.mid(acc, cur, wr, wc, fr, fq); }
            if (last && has_next) S.a_ready(nxt);
            if constexpr (SP2) {
            PG8_LDB(B0, 0, 0); PG8_LDB(B1, 0, 1); PG8_SCHED; PG8_LDA(At, 0, 0); PG8_STAGE(PG8_SA(1, 1), a1 + hstepA, voffA);
            PG8_WAIT_V(8); PG8_WAIT_L(0); PG8_BAR; PG8_MMA(0, 0, At, B0); PG8_MMA(0, 1, At, B1); PG8_BAR; PG8_SCHED;
            PG8_LDA(At, 0, 1); PG8_STAGE(PG8_SB(0, 0), b2, voffB); PG8_STAGE(PG8_SB(0, 1), b2 + hstepB, voffB); PG8_STAGE(PG8_SA(0, 0), a2, voffA);
            PG8_WAIT_V(8); PG8_WAIT_L(0); PG8_BAR; PG8_MMA(1, 0, At, B0); PG8_MMA(1, 1, At, B1); PG8_BAR; PG8_SCHED;
            PG8_LDB(B0, 1, 0); PG8_LDB(B1, 1, 1); PG8_SCHED; PG8_LDA(At, 1, 0); PG8_STAGE(PG8_SA(0, 1), a2 + hstepA, voffA);
            PG8_WAIT_V(8); PG8_WAIT_L(0); PG8_BAR; PG8_MMA(0, 0, At, B0); PG8_MMA(0, 1, At, B1); PG8_BAR; PG8_SCHED;
            PG8_LDA(At, 1, 1); PG8_STAGE(PG8_SB(1, 0), b3, voffB); PG8_STAGE(PG8_SB(1, 1), b3 + hstepB, voffB); PG8_STAGE(PG8_SA(1, 0), a3, voffA);
            PG8_WAIT_V(8); PG8_WAIT_L(0); PG8_BAR; PG8_MMA(1, 0, At, B0); PG8_MMA(1, 1, At, B1); PG8_BAR; PG8_SCHED;
            } else {
            PG8_LDB(B0, 0, 0); PG8_SCHED; PG8_LDA(At, 0, 0); PG8_STAGE(PG8_SA(1, 1), a1 + hstepA, voffA);
            PG8_WAIT_L(8); PG8_BAR; PG8_WAIT_L(0); PG8_MMA(0, 0, At, B0); PG8_BAR; PG8_SCHED;
            PG8_LDB(B1, 0, 1); PG8_STAGE(PG8_SB(0, 0), b2, voffB);
            PG8_BAR; PG8_WAIT_L(0); PG8_MMA(0, 1, At, B1); PG8_BAR;
            PG8_LDA(At, 0, 1); PG8_STAGE(PG8_SA(0, 0), a2, voffA);
            PG8_BAR; PG8_WAIT_L(0); PG8_MMA(1, 0, At, B0); PG8_BAR; PG8_SCHED;
            PG8_STAGE(PG8_SB(0, 1), b2 + hstepB, voffB);
            PG8_WAIT_V(6); PG8_BAR; PG8_MMA(1, 1, At, B1); PG8_BAR;
            PG8_LDB(B0, 1, 0); PG8_SCHED; PG8_LDA(At, 1, 0); PG8_STAGE(PG8_SA(0, 1), a2 + hstepA, voffA);
            PG8_WAIT_L(8); PG8_BAR; PG8_WAIT_L(0); PG8_MMA(0, 0, At, B0); PG8_BAR; PG8_SCHED;
            PG8_LDB(B1, 1, 1); PG8_STAGE(PG8_SB(1, 0), b3, voffB);
            PG8_BAR; PG8_WAIT_L(0); PG8_MMA(0, 1, At, B1); PG8_BAR;
            PG8_LDA(At, 1, 1); PG8_STAGE(PG8_SA(1, 0), a3, voffA);
            PG8_BAR; PG8_WAIT_L(0); PG8_MMA(1, 0, At, B0); PG8_BAR; PG8_SCHED;
            PG8_STAGE(PG8_SB(1, 1), b3 + hstepB, voffB);
            PG8_WAIT_V(6); PG8_BAR; PG8_MMA(1, 1, At, B1); PG8_BAR;
            }
        }
        if constexpr (ALIGN_EPI) { if (wr == 0) PG8_BAR; }
        E(acc, cur, wr, wc, fr, fq); S.done(cur);
        if (!has_next) break;
        E.init(acc, nxt, wr, wc, fr, fq);
        cur = nxt; cA = nA; cB = nB; ++ui;
        if constexpr (ALIGN_EPI) { if (wr == 1) PG8_BAR; }
    }
    PG8_WAIT_V(0);
    if constexpr (!ALIGN_EPI) { if (wr == 0) PG8_BAR; }
    PG8_BAR;
#undef PG8_SA
#undef PG8_SB
#undef PG8_STAGE
#undef PG8_LDA
#undef PG8_LDB
#undef PG8_MMA
#undef PG8_WAIT_V
#undef PG8_WAIT_L
#undef PG8_BAR
#undef PG8_SCHED
}
}

__device__ __forceinline__ float fsigmoid(float x) { return __builtin_amdgcn_rcpf(1.0f + __builtin_amdgcn_exp2f(-L2E * x)); }
__device__ __forceinline__ float bf_lo(unsigned w) { return __builtin_bit_cast(float, w << 16); }
__device__ __forceinline__ float bf_hi(unsigned w) { return __builtin_bit_cast(float, w & 0xffff0000u); }
__device__ __forceinline__ unsigned f2bf(float f) { unsigned u = __builtin_bit_cast(unsigned, f); return (u + 0x7fffu + ((u >> 16) & 1u)) >> 16; }
__device__ __forceinline__ unsigned pk2(float lo, float hi) { return f2bf(lo) | (f2bf(hi) << 16); }
using pg8::cvt_pk_bf16;

__device__ __forceinline__ void acc_zero(f32x4 (&acc)[2][2][4][2]) {
#pragma unroll
    for (int a = 0; a < 2; ++a)
#pragma unroll
        for (int b = 0; b < 2; ++b)
#pragma unroll
            for (int m = 0; m < 4; ++m)
#pragma unroll
                for (int n = 0; n < 2; ++n) acc[a][b][m][n] = (f32x4){0.f, 0.f, 0.f, 0.f};
}
__device__ __forceinline__ float dpp_shr1(float v) { return __builtin_bit_cast(float, __builtin_amdgcn_update_dpp(0, __builtin_bit_cast(int, v), 0x111, 0xf, 0xf, true)); }
struct EpiP1 {
    static constexpr bool PERM = false, HAS_MID = false, ROWPERM = true; static constexpr int MID_T = -2;
    bf16_t* UV; bf16_t* XC; bf16_t* GR; bf16_t* GB; float* SA; float* SB; const float* bgate; const float* cwa; const float* cwb; const float* cbb;
    __device__ __forceinline__ void mid(f32x4 (&)[2][2][4][2], const pg8::Unit&, int, int, int, int) const {}
    __device__ __forceinline__ void init(f32x4 (&acc)[2][2][4][2], const pg8::Unit&, int, int, int, int) const { acc_zero(acc); }
    __device__ __forceinline__ void operator()(const f32x4 (&acc)[2][2][4][2], const pg8::Unit& u, int wr, int wc, int fr, int fq) const {
        int pm_ = u.pm; asm volatile("" : "+s"(pm_));
        const int tok0 = pm_ * 256 + wr * 128 + fr * 8, blk = pm_ * 2 + wr;
        const bool head = (fr == 0), tail = (pm_ == MR / 256) ? (fr == 1) : (fr == 15);
        if (u.pn < 16) {
            const int chl = u.pn * 64 + wc * 16 + 8 * (fq & 1) + 4 * (fq >> 1);
            const f32x4 w0 = *(const f32x4*)(cwa + chl), w1 = *(const f32x4*)(cwa + 1024 + chl), w2 = *(const f32x4*)(cwa + 2048 + chl);
            f32x4 p[8], q[8];
#pragma unroll
            for (int i = 0; i < 8; ++i) { const int ai = i >> 2, m = i & 3; const f32x4 vb = acc[ai][0][m][0], vc = acc[ai][0][m][1], vh = acc[ai][1][m][0], vz = acc[ai][1][m][1];
                p[i] = vc * vh;
#pragma unroll
                for (int j = 0; j < 4; ++j) q[i][j] = vb[j] * vz[j] * fsigmoid(vz[j]); }
            f32x4 pm1, pm2;
#pragma unroll
            for (int j = 0; j < 4; ++j) { pm1[j] = dpp_shr1(p[7][j]); pm2[j] = dpp_shr1(p[6][j]); }
            if (head) { float* s = SA + (size_t)blk * 6144 + chl; *(f32x4*)(s) = p[0]; *(f32x4*)(s + 1024) = p[1]; *(f32x4*)(s + 2048) = q[0]; *(f32x4*)(s + 3072) = q[1]; }
            if (tail) { float* s = SA + (size_t)blk * 6144 + chl; *(f32x4*)(s + 4096) = p[6]; *(f32x4*)(s + 5120) = p[7]; }
            u32x2 pk[8];
#pragma unroll
            for (int i = 0; i < 8; ++i) { const f32x4 a1 = (i >= 1) ? p[i >= 1 ? i - 1 : 0] : pm1, a2 = (i >= 2) ? p[i >= 2 ? i - 2 : 0] : ((i == 1) ? pm1 : pm2);
                const f32x4 uu = q[i] * (w2 * p[i] + w1 * a1 + w0 * a2);
                pk[i].x = cvt_pk_bf16(uu[0], uu[1]); pk[i].y = cvt_pk_bf16(uu[2], uu[3]); }
            bf16_t* dst = UV + (size_t)(tok0 + (fq >> 1)) * 2048 + u.pn * 64 + wc * 16 + 8 * (fq & 1);
#pragma unroll
            for (int k = 0; k < 4; ++k) {
                const auto rx = __builtin_amdgcn_permlane32_swap(pk[2 * k].x, pk[2 * k + 1].x, false, false);
                const auto ry = __builtin_amdgcn_permlane32_swap(pk[2 * k].y, pk[2 * k + 1].y, false, false);
                *(u32x4*)(dst + (size_t)(2 * k) * 2048) = (u32x4){rx[0], ry[0], rx[1], ry[1]}; }
        } else if (u.pn < 24) {
            const int chl = (u.pn - 16) * 128 + wc * 32 + 8 * fq;
            f32x4 wb[4][2], bb[2];
#pragma unroll
            for (int k = 0; k < 4; ++k) { wb[k][0] = *(const f32x4*)(cwb + k * 1024 + chl); wb[k][1] = *(const f32x4*)(cwb + k * 1024 + chl + 4); }
            bb[0] = *(const f32x4*)(cbb + chl); bb[1] = *(const f32x4*)(cbb + chl + 4);
            f32x4 xm[3][2];
#pragma unroll
            for (int h = 0; h < 2; ++h)
#pragma unroll
                for (int j = 0; j < 4; ++j) { xm[0][h][j] = dpp_shr1(acc[1][0][3][h][j]); xm[1][h][j] = dpp_shr1(acc[1][0][2][h][j]); xm[2][h][j] = dpp_shr1(acc[1][0][1][h][j]); }
            if (head) { float* s = SB + (size_t)blk * 6144 + chl;
#pragma unroll
                for (int i = 0; i < 3; ++i) { *(f32x4*)(s + i * 1024) = acc[0][0][i][0]; *(f32x4*)(s + i * 1024 + 4) = acc[0][0][i][1]; } }
            if (tail) { float* s = SB + (size_t)blk * 6144 + chl;
#pragma unroll
                for (int i = 0; i < 3; ++i) { *(f32x4*)(s + (3 + i) * 1024) = acc[1][0][1 + i][0]; *(f32x4*)(s + (3 + i) * 1024 + 4) = acc[1][0][1 + i][1]; } }
#pragma unroll
            for (int i = 0; i < 8; ++i) { const int ai = i >> 2, m = i & 3; u32x4 ox, oz;
                unsigned wx[4], wz[4];
#pragma unroll
                for (int h = 0; h < 2; ++h) {
                    const f32x4 x0 = acc[ai][0][m][h];
                    const f32x4 x1 = (i >= 1) ? acc[(i >= 1 ? i - 1 : 0) >> 2][0][(i >= 1 ? i - 1 : 0) & 3][h] : xm[0][h];
                    const f32x4 x2 = (i >= 2) ? acc[(i >= 2 ? i - 2 : 0) >> 2][0][(i >= 2 ? i - 2 : 0) & 3][h] : xm[1 - i][h];
                    const f32x4 x3 = (i >= 3) ? acc[(i >= 3 ? i - 3 : 0) >> 2][0][(i >= 3 ? i - 3 : 0) & 3][h] : xm[2 - i][h];
                    const f32x4 xc = wb[0][h] * x3 + wb[1][h] * x2 + wb[2][h] * x1 + wb[3][h] * x0 + bb[h];
                    const f32x4 vz = acc[ai][1][m][h]; f32x4 sz;
#pragma unroll
                    for (int j = 0; j < 4; ++j) sz[j] = vz[j] * fsigmoid(vz[j]);
                    wx[2 * h] = cvt_pk_bf16(xc[0], xc[1]); wx[2 * h + 1] = cvt_pk_bf16(xc[2], xc[3]);
                    wz[2 * h] = cvt_pk_bf16(sz[0], sz[1]); wz[2 * h + 1] = cvt_pk_bf16(sz[2], sz[3]); }
                ox = (u32x4){wx[0], wx[1], wx[2], wx[3]}; oz = (u32x4){wz[0], wz[1], wz[2], wz[3]};
                *(u32x4*)(XC + (size_t)(tok0 + i) * 1024 + chl) = ox;
                *(u32x4*)(UV + (size_t)(tok0 + i) * 2048 + 1024 + chl) = oz; }
        } else {
            const int chl = (u.pn - 24) * 128 + wc * 32 + 8 * fq;
            f32x4 bga[2], bgb[2];
#pragma unroll
            for (int h = 0; h < 2; ++h) { bga[h] = *(const f32x4*)(bgate + chl + 4 * h); bgb[h] = *(const f32x4*)(bgate + 1024 + chl + 4 * h); }
#pragma unroll
            for (int i = 0; i < 8; ++i) { const int ai = i >> 2, m = i & 3; unsigned wr_[4], wb_[4];
#pragma unroll
                for (int h = 0; h < 2; ++h) { const f32x4 va = acc[ai][0][m][h], vb = acc[ai][1][m][h]; f32x4 gr, gb;
#pragma unroll
                    for (int j = 0; j < 4; ++j) {
                        const float ea = __builtin_amdgcn_exp2f(-L2E * (va[j] + bga[h][j]));
                        const float eb = __builtin_amdgcn_exp2f(-L2E * fmaxf(vb[j] + bgb[h][j], -60.f));
                        gb[j] = __builtin_amdgcn_rcpf(1.0f + eb);
                        gr[j] = __builtin_amdgcn_rcpf(1.0f + ea) * (1.0f + eb); }
                    wr_[2 * h] = cvt_pk_bf16(gr[0], gr[1]); wr_[2 * h + 1] = cvt_pk_bf16(gr[2], gr[3]);
                    wb_[2 * h] = cvt_pk_bf16(gb[0], gb[1]); wb_[2 * h + 1] = cvt_pk_bf16(gb[2], gb[3]); }
                *(u32x4*)(GR + (size_t)(tok0 + i) * 1024 + chl) = (u32x4){wr_[0], wr_[1], wr_[2], wr_[3]};
                *(u32x4*)(GB + (size_t)(tok0 + i) * 1024 + chl) = (u32x4){wb_[0], wb_[1], wb_[2], wb_[3]}; }
        }
    }
};

struct EpiP3 {
    static constexpr bool PERM = true, HAS_MID = true, ROWPERM = false; static constexpr int MID_T = 16;
    const bf16_t* GR; const bf16_t* GB; bf16_t* MG;
    __device__ __forceinline__ void init(f32x4 (&acc)[2][2][4][2], const pg8::Unit&, int, int, int, int) const { acc_zero(acc); }
    __device__ __forceinline__ void mid(f32x4 (&acc)[2][2][4][2], const pg8::Unit& u, int wr, int wc, int fr, int fq) const {
        int pm_ = u.pm; asm volatile("" : "+s"(pm_));
        const int row0 = pm_ * 256 + wr * 64 + fr, col0 = u.pn * 256 + wc * 32 + 8 * fq;
#pragma unroll
        for (int ai = 0; ai < 2; ++ai)
#pragma unroll
            for (int m = 0; m < 4; ++m) { const bf16_t* rp = GR + (size_t)(row0 + ai * 128 + m * 16) * 1024 + col0;
#pragma unroll
                for (int bj = 0; bj < 2; ++bj) { const u32x4 w = *(const u32x4*)(rp + bj * 128);
                    acc[ai][bj][m][0] *= (f32x4){bf_lo(w.x), bf_hi(w.x), bf_lo(w.y), bf_hi(w.y)};
                    acc[ai][bj][m][1] *= (f32x4){bf_lo(w.z), bf_hi(w.z), bf_lo(w.w), bf_hi(w.w)}; } }
    }
    __device__ __forceinline__ void operator()(const f32x4 (&acc)[2][2][4][2], const pg8::Unit& u, int wr, int wc, int fr, int fq) const {
        int pm_ = u.pm; asm volatile("" : "+s"(pm_));
        const int row0 = pm_ * 256 + wr * 64 + fr, col0 = u.pn * 256 + wc * 32 + 8 * fq;
        u32x4 w[2][4][2];
#pragma unroll
        for (int ai = 0; ai < 2; ++ai)
#pragma unroll
            for (int m = 0; m < 4; ++m)
#pragma unroll
                for (int bj = 0; bj < 2; ++bj) w[ai][m][bj] = *(const u32x4*)(GB + (size_t)(row0 + ai * 128 + m * 16) * 1024 + col0 + bj * 128);
#pragma unroll
        for (int ai = 0; ai < 2; ++ai)
#pragma unroll
            for (int m = 0; m < 4; ++m) { const size_t off = (size_t)(row0 + ai * 128 + m * 16) * 1024 + col0;
#pragma unroll
                for (int bj = 0; bj < 2; ++bj) { const u32x4 ww = w[ai][m][bj];
                    const f32x4 v0 = acc[ai][bj][m][0] * (f32x4){bf_lo(ww.x), bf_hi(ww.x), bf_lo(ww.y), bf_hi(ww.y)};
                    const f32x4 v1 = acc[ai][bj][m][1] * (f32x4){bf_lo(ww.z), bf_hi(ww.z), bf_lo(ww.w), bf_hi(ww.w)};
                    u32x4 o; o.x = cvt_pk_bf16(v0[0], v0[1]); o.y = cvt_pk_bf16(v0[2], v0[3]); o.z = cvt_pk_bf16(v1[0], v1[1]); o.w = cvt_pk_bf16(v1[2], v1[3]);
                    *(u32x4*)(MG + off + bj * 128) = o; } }
    }
};

struct EpiP4 {
    static constexpr bool PERM = false, HAS_MID = false, ROWPERM = false; static constexpr int MID_T = -2;
    const float* X; float* OUT; float* RS;
    __device__ __forceinline__ void mid(f32x4 (&)[2][2][4][2], const pg8::Unit&, int, int, int, int) const {}
    __device__ __forceinline__ void init(f32x4 (&acc)[2][2][4][2], const pg8::Unit& u, int wr, int wc, int fr, int fq) const {
        int pm_ = u.pm; asm volatile("" : "+s"(pm_));
        const int row0 = pm_ * 256 + wr * 64 + fr, col0 = u.pn * 256 + wc * 32 + 4 * fq;
#pragma unroll
        for (int ai = 0; ai < 2; ++ai)
#pragma unroll
            for (int m = 0; m < 4; ++m) { const float* xp = X + (size_t)(row0 + ai * 128 + m * 16) * 1024 + col0;
#pragma unroll
                for (int bj = 0; bj < 2; ++bj) { acc[ai][bj][m][0] = *(const f32x4*)(xp + bj * 128); acc[ai][bj][m][1] = *(const f32x4*)(xp + bj * 128 + 16); } }
    }
    __device__ __forceinline__ void operator()(const f32x4 (&acc)[2][2][4][2], const pg8::Unit& u, int wr, int wc, int fr, int fq) const {
        int pm_ = u.pm; asm volatile("" : "+s"(pm_));
        const int row0 = pm_ * 256 + wr * 64 + fr, col0 = u.pn * 256 + wc * 32 + 4 * fq;
#pragma unroll
        for (int ai = 0; ai < 2; ++ai)
#pragma unroll
            for (int m = 0; m < 4; ++m) { const int row = row0 + ai * 128 + m * 16; const size_t off = (size_t)row * 1024 + col0; float s = 0.f;
#pragma unroll
                for (int bj = 0; bj < 2; ++bj) {
                    const f32x4 h0 = acc[ai][bj][m][0], h1 = acc[ai][bj][m][1];
                    s += (h0[0] * h0[0] + h0[1] * h0[1]) + (h0[2] * h0[2] + h0[3] * h0[3]) + (h1[0] * h1[0] + h1[1] * h1[1]) + (h1[2] * h1[2] + h1[3] * h1[3]);
                    *(f32x4*)(OUT + off + bj * 128) = h0; *(f32x4*)(OUT + off + bj * 128 + 16) = h1; }
                s += __shfl_xor(s, 16); s += __shfl_xor(s, 32);
                if (fq == 0) atomicAdd(RS + row, s); }
    }
};

constexpr int RING_OFF = 0, RING_BYTES = 131072;
constexpr int LDSCTL_OFF = RING_BYTES, MISC_OFF = LDSCTL_OFF + 320;
constexpr int LDS_BYTES = 147456;
constexpr int NWAVES = 8;

typedef GAS unsigned gu32;
#define RLX_AGENT __ATOMIC_RELAXED, __HIP_MEMORY_SCOPE_AGENT
#define LDS_WAIT() asm volatile("s_waitcnt lgkmcnt(0)" ::: "memory")
#define VM_WAIT() asm volatile("s_waitcnt vmcnt(0)" ::: "memory")

#define XB_TMO      128
#define XB_XCNT(j)  (256  + 64 * (j))
#define XB_XSUB(j)  (1280 + 64 * (j))
#define XB_XGEN(j)  (2304 + 64 * (j))
#define XB_TOP      3328
#define XB_TOPGEN   3392
#define XCD_BAR_WORDS 3456
#define XB_SPIN_CAP (1u << 22)
constexpr int CW_BAR = 4096;

__device__ __forceinline__ unsigned xb_ld(unsigned* p)              { return __hip_atomic_load(p, __ATOMIC_RELAXED, __HIP_MEMORY_SCOPE_AGENT); }
__device__ __forceinline__ unsigned xb_add(unsigned* p, unsigned v) { return __hip_atomic_fetch_add(p, v, __ATOMIC_RELAXED, __HIP_MEMORY_SCOPE_AGENT); }
__device__ __forceinline__ unsigned xb_xcc_id() { return (unsigned)__builtin_amdgcn_s_getreg((3 << 11) | 20) & 0xFu; }
#define XB_SPIN(cond, bar) do { unsigned _sp = 0; while (cond) { __builtin_amdgcn_s_sleep(1); \
    if ((++_sp & 255u) == 0u) { if (xb_ld(&(bar)[XB_TMO])) break; if (_sp > XB_SPIN_CAP) { atomicAdd(&(bar)[XB_TMO], 1u); break; } } } } while (0)

struct XcdBarrier { unsigned* bar; unsigned x; volatile LAS unsigned* st; };

__device__ __forceinline__ XcdBarrier xcd_barrier_post(unsigned* bar, volatile LAS unsigned* st) {
    XcdBarrier b; b.bar = bar; b.x = xb_xcc_id(); b.st = st;
    if (threadIdx.x == 0) (void)xb_add(&bar[XB_XCNT(b.x)], 1u);
    return b;
}
__device__ __forceinline__ void xcd_barrier_complete(unsigned* bar, unsigned x, unsigned& nloc, unsigned& nx) {
    const unsigned G = gridDim.x * gridDim.y * gridDim.z;
    unsigned sum, cnt, mine, sp = 0u;
    for (;;) {
        sum = 0u; cnt = 0u; mine = 0u;
#pragma unroll
        for (unsigned j = 0; j < 16; ++j) { const unsigned c = xb_ld(&bar[XB_XCNT(j)]); sum += c; cnt += (c > 0u) ? 1u : 0u; mine = (j == x) ? c : mine; }
        if (sum == G) break;
        __builtin_amdgcn_s_sleep(1);
        if ((++sp & 255u) == 0u) { if (xb_ld(&bar[XB_TMO])) break; if (sp > XB_SPIN_CAP) { atomicAdd(&bar[XB_TMO], 1u); break; } }
    }
    nloc = mine > 0u ? mine : 1u; nx = cnt > 0u ? cnt : 1u;
}
__device__ __forceinline__ void xcd_barrier(const XcdBarrier& b) {
    asm volatile("s_waitcnt vmcnt(0)" ::: "memory");
    __syncthreads();
    if (threadIdx.x == 0) {
        unsigned* bar = b.bar;
        __builtin_amdgcn_s_waitcnt(0);
        unsigned nloc = b.st[0], nx = b.st[1];
        if (nloc == 0u) { xcd_barrier_complete(bar, b.x, nloc, nx); b.st[0] = nloc; b.st[1] = nx; }
        const unsigned old = xb_add(&bar[XB_XSUB(b.x)], 1u);
        const unsigned gen = old / nloc;
        if (old + 1u == (gen + 1u) * nloc) {
            __builtin_amdgcn_fence(__ATOMIC_RELEASE, "agent");
            asm volatile("s_waitcnt vmcnt(0)" ::: "memory");
            const unsigned og = xb_add(&bar[XB_TOP], 1u);
            const unsigned tg = og / nx;
            if (og + 1u == (tg + 1u) * nx) xb_add(&bar[XB_TOPGEN], 1u);
            else XB_SPIN(xb_ld(&bar[XB_TOPGEN]) == tg, bar);
            __builtin_amdgcn_fence(__ATOMIC_ACQUIRE, "agent");
            xb_add(&bar[XB_XGEN(b.x)], 1u);
            asm volatile("s_waitcnt vmcnt(0)" ::: "memory");
        } else {
            XB_SPIN(xb_ld(&bar[XB_XGEN(b.x)]) == gen, bar);
            __builtin_amdgcn_fence(__ATOMIC_ACQUIRE, "agent");
            asm volatile("s_waitcnt vmcnt(0)" ::: "memory");
        }
    }
    __syncthreads();
}

struct Frame {
    LAS unsigned char* lds;
    volatile LAS unsigned* MISC;
    gu32* ctl;
    int tid, lane, wave, vcu, G;
    const float *x, *meta, *norm_g, *w_in, *b_gate, *conv_a_w, *w_proj_a, *conv_b_w, *conv_b_b, *w_rg_a, *b_rg_a, *w_rg_i, *b_rg_i, *lru, *w_proj_b, *w_out, *fin_g;
    float* out; float* RS;
    bf16_t *WinT, *WabT, *WoutT, *WgaT, *WgiT;
    bf16_t *XN, *XC, *UV, *GR, *GB;
    float *SA, *SB;
};

__device__ __forceinline__ float wave_sum(float v) {
#pragma unroll
    for (int o = 1; o < 64; o <<= 1) v += __shfl_xor(v, o);
    return v;
}

template <class FMap>
__device__ __forceinline__ void p0_transpose_item(const float* W, int Nsrc, bf16_t* WT, int ldo, int col_off, LAS float* scr, int kb, int nb, int lane, FMap fmap) {
    const int k0 = 64 * kb, n0 = 32 * nb;
    const int fsrc = fmap(n0 + (lane & 31));
#pragma unroll 8
    for (int i = 0; i < 32; ++i) { const int kk = 2 * i + (lane >> 5); scr[kk * 33 + (lane & 31)] = W[(size_t)(k0 + kk) * Nsrc + fsrc]; }
    LDS_WAIT(); asm volatile("" ::: "memory");
    const int c = lane & 7;
#pragma unroll
    for (int j = 0; j < 4; ++j) { const int n = (lane >> 3) + 8 * j; const LAS float* s = scr + (8 * c) * 33 + n;
        u32x4 o; o.x = pk2(s[0 * 33], s[1 * 33]); o.y = pk2(s[2 * 33], s[3 * 33]); o.z = pk2(s[4 * 33], s[5 * 33]); o.w = pk2(s[6 * 33], s[7 * 33]);
        *(GAS u32x4*)(WT + (size_t)(n0 + n) * ldo + col_off + k0 + 8 * c) = o; }
    LDS_WAIT(); asm volatile("" ::: "memory");
}
struct FIdent { __device__ __forceinline__ int operator()(int n) const { return n; } };
struct FWin {
    __device__ __forceinline__ int operator()(int np) const {
        const int pn = np >> 8, s = np & 255;
        const int bj = s >> 7, wc = (s >> 5) & 3, n = (s >> 4) & 1, fq = (s >> 2) & 3, j = s & 3;
        if (pn < 16) return (2 * bj + n) * 1024 + pn * 64 + wc * 16 + 8 * (fq & 1) + 4 * (fq >> 1) + j;
        const int gb = (pn < 24) ? 4 : 6, cb2 = (pn - 16) & 7;
        return (gb + bj) * 1024 + cb2 * 128 + wc * 32 + 8 * fq + 4 * n + j;
    }
};

__device__ __forceinline__ void rms_row_to_bf16(const float* xrow, const float* g, bf16_t* orow, int lane) {
    const GAS f32x4* xr = (const GAS f32x4*)xrow + lane; const GAS f32x4* gr = (const GAS f32x4*)g + lane;
    f32x4 v[4]; float s = 0.f;
#pragma unroll
    for (int j = 0; j < 4; ++j) { v[j] = xr[64 * j]; s += (v[j].x * v[j].x + v[j].y * v[j].y) + (v[j].z * v[j].z + v[j].w * v[j].w); }
    const float rstd = 1.0f / sqrtf(wave_sum(s) * (1.f / D) + RMS_EPS);
    GAS u32x2* o8 = (GAS u32x2*)orow + lane;
#pragma unroll
    for (int j = 0; j < 4; ++j) { const f32x4 gg = gr[64 * j]; u32x2 w; w.x = pk2(v[j].x * rstd * gg.x, v[j].y * rstd * gg.y); w.y = pk2(v[j].z * rstd * gg.z, v[j].w * rstd * gg.w); o8[64 * j] = w; }
}

__device__ __forceinline__ void p0_prologue(Frame& F) {
    LAS float* scr = (LAS float*)(F.lds + RING_OFF + F.wave * 16384);
    const int gw = F.vcu * NWAVES + F.wave, NGW = F.G * NWAVES;
    constexpr int I_IN = 16 * 256, I_P = 16 * 32, I_G = 4 * 4 * 8;
    constexpr int NITEMS = I_IN + 3 * I_P + 2 * I_G;
    for (int it = gw; it < NITEMS; it += NGW) {
        int r = it;
        if (r < I_IN) { p0_transpose_item(F.w_in, NIN, F.WinT, 1024, 0, scr, r / 256, r % 256, F.lane, FWin()); continue; } r -= I_IN;
        if (r < I_P) { p0_transpose_item(F.w_proj_a, 1024, F.WabT, 2048, 0, scr, r / 32, r % 32, F.lane, FIdent()); continue; } r -= I_P;
        if (r < I_P) { p0_transpose_item(F.w_proj_b, 1024, F.WabT, 2048, 1024, scr, r / 32, r % 32, F.lane, FIdent()); continue; } r -= I_P;
        if (r < I_P) { p0_transpose_item(F.w_out, 1024, F.WoutT, 1024, 0, scr, r / 32, r % 32, F.lane, FIdent()); continue; } r -= I_P;
        if (r < I_G) { const int h = r / 32, q = r % 32; p0_transpose_item(F.w_rg_a + (size_t)h * 65536, 256, F.WgaT + (size_t)h * 65536, 256, 0, scr, q / 8, q % 8, F.lane, FIdent()); continue; } r -= I_G;
        { const int h = r / 32, q = r % 32; p0_transpose_item(F.w_rg_i + (size_t)h * 65536, 256, F.WgiT + (size_t)h * 65536, 256, 0, scr, q / 8, q % 8, F.lane, FIdent()); }
    }
    for (int m = gw; m < MP; m += NGW) {
        bf16_t* orow = F.XN + (size_t)m * D;
        if (m < MR) rms_row_to_bf16(F.x + (size_t)m * D, F.norm_g, orow, F.lane);
        else if (m < MR + NMETA) rms_row_to_bf16(F.meta + (size_t)(m - MR) * D, F.norm_g, orow, F.lane);
        else { GAS u32x4* o = (GAS u32x4*)orow + F.lane; o[0] = (u32x4){0u, 0u, 0u, 0u}; o[64] = (u32x4){0u, 0u, 0u, 0u}; }
    }
}

__device__ __forceinline__ void p2_fixup(Frame& F, int b, int head, int chb) {
    bf16_t* XC = F.XC;
#pragma unroll 1
    for (int idx = F.tid; idx < 33 * 256; idx += NWAVES * 64) {
        const int bi = idx >> 8, ch = head * 256 + (idx & 255);
        const int blk = bi < 32 ? b * 32 + bi : 512, prev = bi == 32 ? -1 : (bi > 0 ? blk - 1 : 512);
        const int rowbase = bi < 32 ? b * SEQ + bi * 128 : MR;
        const float* sb = F.SB + (size_t)blk * 6144 + ch;
        float h0 = 0.f, h1 = 0.f, h2 = 0.f;
        if (prev >= 0) { const float* sp = F.SB + (size_t)prev * 6144 + ch; h0 = sp[3072]; h1 = sp[4096]; h2 = sp[5120]; }
        const float x0 = sb[0], x1 = sb[1024], x2 = sb[2048];
        const float w0 = F.conv_b_w[ch], w1 = F.conv_b_w[1024 + ch], w2 = F.conv_b_w[2048 + ch], w3 = F.conv_b_w[3072 + ch], bb = F.conv_b_b[ch];
        const float c0 = w0 * h0 + w1 * h1 + w2 * h2 + w3 * x0 + bb, c1 = w0 * h1 + w1 * h2 + w2 * x0 + w3 * x1 + bb, c2 = w0 * h2 + w1 * x0 + w2 * x1 + w3 * x2 + bb;
        XC[(size_t)(rowbase + 0) * 1024 + ch] = (bf16_t)f2bf(c0); XC[(size_t)(rowbase + 1) * 1024 + ch] = (bf16_t)f2bf(c1); XC[(size_t)(rowbase + 2) * 1024 + ch] = (bf16_t)f2bf(c2);
    }
#pragma unroll 1
    for (int idx = F.tid; idx < 32 * 64; idx += NWAVES * 64) {
        const int bi = idx >> 6, ch = chb + (idx & 63);
        const int blk = b * 32 + bi, prev = bi > 0 ? blk - 1 : 512, rowbase = b * SEQ + bi * 128;
        const float* sa = F.SA + (size_t)blk * 6144 + ch; const float* sp = F.SA + (size_t)prev * 6144 + ch;
        const float t0 = sp[4096], t1 = sp[5120], p0 = sa[0], p1 = sa[1024], q0 = sa[2048], q1 = sa[3072];
        const float w0 = F.conv_a_w[ch], w1 = F.conv_a_w[1024 + ch], w2 = F.conv_a_w[2048 + ch];
        const float u0 = q0 * (w2 * p0 + w1 * t1 + w0 * t0), u1 = q1 * (w2 * p1 + w1 * p0 + w0 * t1);
        F.UV[(size_t)(rowbase + 0) * 2048 + ch] = (bf16_t)f2bf(u0); F.UV[(size_t)(rowbase + 1) * 2048 + ch] = (bf16_t)f2bf(u1);
    }
    VM_WAIT();
    __builtin_amdgcn_fence(__ATOMIC_ACQUIRE, "agent");
    VM_WAIT();
    __syncthreads();
}

constexpr int P2_W_BYTES = 65536, P2_AGG_OFF = 65536;

__device__ __forceinline__ int tok_of(int rho, int hh) { return (rho & 3) + 8 * (rho >> 2) + 4 * hh; }

template <bool META>
__device__ __forceinline__ void p2_slab(LAS const unsigned char* wl, const bf16_t* XC, int R0, int kbase, int chb, int lane,
                                        const float (&ba)[2], const float (&bi)[2], const float (&nsp)[2],
                                        float (&cumA)[2][16], float (&hloc)[2][16]) {
    const int c = lane & 31, hh = lane >> 5;
    const int rowA = META ? MR + (c & 15) : R0 + c;
    const int rowbase = META ? MR - 16 : R0;
    const GAS bf16x8* ap = (const GAS bf16x8*)(XC + (size_t)rowA * 1024 + kbase + 8 * hh);
    f32x16 acc[4];
#pragma unroll
    for (int s = 0; s < 4; ++s)
#pragma unroll
        for (int r = 0; r < 16; ++r) acc[s][r] = 0.f;
    const unsigned rowoff = (unsigned)c * 512u; const int x15 = lane & 15;
#pragma unroll
    for (int kh = 0; kh < 2; ++kh) {
        bf16x8 af[8];
#pragma unroll
        for (int k8 = 0; k8 < 8; ++k8) af[k8] = ap[2 * (8 * kh + k8)];
#pragma unroll
        for (int k8 = 0; k8 < 8; ++k8) { const int ks = 8 * kh + k8;
            const unsigned boff = rowoff + ((unsigned)((2 * ks + hh) ^ x15) << 4);
#pragma unroll
            for (int s = 0; s < 4; ++s) { const bf16x8 b = *(const LAS bf16x8*)(wl + boff + s * 16384);
                acc[s] = __builtin_amdgcn_mfma_f32_32x32x16_bf16(af[k8], b, acc[s], 0, 0, 0); }
        }
        asm volatile("" ::: "memory");
    }
    unsigned xcv[16];
#pragma unroll
    for (int rho = 0; rho < 16; ++rho) { if (META && rho < 8) { xcv[rho] = 0u; continue; }
        xcv[rho] = *(const GAS unsigned*)(XC + (size_t)(rowbase + tok_of(rho, hh)) * 1024 + chb + 2 * c); }
#pragma unroll
    for (int s2 = 0; s2 < 2; ++s2)
#pragma unroll
        for (int rho = 0; rho < 16; ++rho) {
            if (META && rho < 8) { cumA[s2][rho] = 1.f; hloc[s2][rho] = 0.f; continue; }
            const float r = fsigmoid(acc[s2][rho] + ba[s2]);
            const float ig = fsigmoid(acc[2 + s2][rho] + bi[s2]);
            const float la = nsp[s2] * r;
            const float a = __builtin_amdgcn_exp2f(la * L2E);
            const float y = 2.f * la;
            const float om_ser = -y * (1.f + y * (0.5f + y * (0.16666667f + y * 0.041666667f)));
            const float om = (y > -0.05f) ? om_ser : (1.f - a * a);
            float mult = __builtin_amdgcn_sqrtf(om);
            if (META && rho == 8) mult = (hh == 0) ? 1.f : mult;
            const float xc = s2 ? bf_hi(xcv[rho]) : bf_lo(xcv[rho]);
            cumA[s2][rho] = a; hloc[s2][rho] = xc * ig * mult;
        }
#pragma unroll
    for (int s2 = 0; s2 < 2; ++s2)
#pragma unroll
        for (int g = 0; g < 4; ++g) { const int b = 4 * g;
            hloc[s2][b + 1] = cumA[s2][b + 1] * hloc[s2][b] + hloc[s2][b + 1];
            hloc[s2][b + 2] = cumA[s2][b + 2] * hloc[s2][b + 1] + hloc[s2][b + 2];
            hloc[s2][b + 3] = cumA[s2][b + 3] * hloc[s2][b + 2] + hloc[s2][b + 3];
            cumA[s2][b + 1] *= cumA[s2][b]; cumA[s2][b + 2] *= cumA[s2][b + 1]; cumA[s2][b + 3] *= cumA[s2][b + 2]; }
}

__device__ __forceinline__ void p2_group_prefix(const float (&cumA)[2][16], const float (&hloc)[2][16], int hh, float (&exP)[2][4], float (&exS)[2][4], float (&slP)[2], float (&slS)[2]) {
#pragma unroll
    for (int s2 = 0; s2 < 2; ++s2) {
        float runP = 1.f, runS = 0.f;
#pragma unroll
        for (int g = 0; g < 4; ++g) {
            const auto pp = __builtin_amdgcn_permlane32_swap(__float_as_uint(cumA[s2][4 * g + 3]), __float_as_uint(cumA[s2][4 * g + 3]), false, false);
            const auto ss = __builtin_amdgcn_permlane32_swap(__float_as_uint(hloc[s2][4 * g + 3]), __float_as_uint(hloc[s2][4 * g + 3]), false, false);
            const float Pe = __uint_as_float(pp[0]), Po = __uint_as_float(pp[1]), Se = __uint_as_float(ss[0]), So = __uint_as_float(ss[1]);
            const float ePe = runP, eSe = runS; runS = Pe * runS + Se; runP = Pe * runP;
            const float ePo = runP, eSo = runS; runS = Po * runS + So; runP = Po * runP;
            exP[s2][g] = hh ? ePo : ePe; exS[s2][g] = hh ? eSo : eSe;
        }
        slP[s2] = runP; slS[s2] = runS;
    }
}

__device__ __forceinline__ void p2_scan(Frame& F) {
    LAS unsigned char* wl = F.lds + RING_OFF;
    LAS float* agg = (LAS float*)(F.lds + RING_OFF + P2_AGG_OFF);
    const bf16_t* XC = F.XC;
    const int w = F.wave;
    for (int chain = F.vcu; chain < NBATCH * 16; chain += F.G) {
        const int cg = chain & 3, head = (chain >> 2) & 3, b = chain >> 4;
        const int kbase = head * 256, chb = head * 256 + cg * 64;
        __syncthreads();
        p2_fixup(F, b, head, chb);
        int lane = F.lane; asm volatile("" : "+v"(lane));
        const int c = lane & 31, hh = lane >> 5;
#pragma unroll 2
        for (int idx = F.tid; idx < 128 * 32; idx += NWAVES * 64) {
            const int n = idx >> 5, q = idx & 31, s = n >> 5, cc = n & 31;
            const int chl = 2 * cc + (s & 1);
            const bf16_t* src = ((s < 2) ? F.WgaT : F.WgiT) + (size_t)head * 65536 + (size_t)(cg * 64 + chl) * 256 + q * 8;
            *(LAS u32x4*)(wl + n * 512 + ((q ^ (n & 15)) << 4)) = *(const GAS u32x4*)src;
        }
        float ba[2], bi[2], nsp[2];
#pragma unroll
        for (int s2 = 0; s2 < 2; ++s2) { const int ch = chb + 2 * c + s2; ba[s2] = F.b_rg_a[ch]; bi[s2] = F.b_rg_i[ch]; nsp[s2] = -8.0f * log1pf(expf(-F.lru[ch])); }
        LDS_WAIT();
        __syncthreads();
        float carry[2];
        float cumA[2][16], hloc[2][16], exP[2][4], exS[2][4], slP[2], slS[2];
        p2_slab<true>(wl, XC, 0, kbase, chb, lane, ba, bi, nsp, cumA, hloc);
        p2_group_prefix(cumA, hloc, hh, exP, exS, slP, slS);
        carry[0] = slS[0]; carry[1] = slS[1];
        for (int j = 0; j < SEQ / 256; ++j) {
            const int R0 = b * SEQ + j * 256 + w * 32;
            p2_slab<false>(wl, XC, R0, kbase, chb, lane, ba, bi, nsp, cumA, hloc);
            asm volatile("" ::: "memory");
            unsigned szv[16];
#pragma unroll
            for (int rho = 0; rho < 16; ++rho) szv[rho] = *(const GAS unsigned*)(F.UV + (size_t)(R0 + tok_of(rho, hh)) * 2048 + 1024 + chb + 2 * c);
            p2_group_prefix(cumA, hloc, hh, exP, exS, slP, slS);
            LAS float* ag = agg + (j & 1) * 1024;
            if (hh == 0) *(LAS f32x4*)(ag + w * 128 + c * 4) = (f32x4){slP[0], slS[0], slP[1], slS[1]};
            LDS_WAIT();
            __syncthreads();
            float cs[2] = {carry[0], carry[1]}, run[2] = {carry[0], carry[1]};
#pragma unroll
            for (int ww = 0; ww < 8; ++ww) { const f32x4 e = *(const LAS f32x4*)(ag + ww * 128 + c * 4);
                if (ww == w) { cs[0] = run[0]; cs[1] = run[1]; }
                run[0] = e[0] * run[0] + e[1]; run[1] = e[2] * run[1] + e[3]; }
            carry[0] = run[0]; carry[1] = run[1];
#pragma unroll
            for (int g = 0; g < 4; ++g) {
                const float cg0 = exP[0][g] * cs[0] + exS[0][g], cg1 = exP[1][g] * cs[1] + exS[1][g];
#pragma unroll
                for (int t = 0; t < 4; ++t) { const int rho = 4 * g + t;
                    const float h0 = hloc[0][rho] + cumA[0][rho] * cg0, h1 = hloc[1][rho] + cumA[1][rho] * cg1;
                    unsigned sz_ = szv[rho]; asm volatile("" : "+v"(sz_));
                    const unsigned o = cvt_pk_bf16(h0 * bf_lo(sz_), h1 * bf_hi(sz_));
                    *(GAS unsigned*)(F.UV + (size_t)(R0 + tok_of(rho, hh)) * 2048 + 1024 + chb + 2 * c) = o; }
                asm volatile("" ::: "memory");
            }
        }
    }
    __syncthreads();
}

__device__ __forceinline__ void p5_final(Frame& F) {
    const int gw = F.vcu * NWAVES + F.wave, NGW = F.G * NWAVES;
    for (int m = gw; m < MR; m += NGW) {
        const float rstd = 1.0f / sqrtf(F.RS[m] * (1.f / D) + RMS_EPS);
        GAS f32x4* o = (GAS f32x4*)(F.out + (size_t)m * D) + F.lane; const GAS f32x4* gr = (const GAS f32x4*)F.fin_g + F.lane;
#pragma unroll
        for (int j = 0; j < 4; ++j) { const f32x4 v = o[64 * j], gg = gr[64 * j]; o[64 * j] = v * rstd * gg; }
    }
}

__device__ __forceinline__ void stagger_delay(int ticks) {
    if (ticks > 0 && (blockIdx.x & 128)) { const unsigned long long t0 = __builtin_amdgcn_s_memrealtime(); while (__builtin_amdgcn_s_memrealtime() - t0 < (unsigned long long)ticks) __builtin_amdgcn_s_sleep(32); }
    __syncthreads();
}
#ifndef STG1
#define STG1 0
#endif
#ifndef STG4
#define STG4 0
#endif
#ifndef STG5
#define STG5 0
#endif
constexpr int PER_PHASE = 7;
constexpr int N_LAUNCHES = MK_N_LAUNCHES;
struct Args { const float* in[17]; float* out; unsigned char* ws; int ph_lo, ph_hi, li, pad; };

__global__ void __launch_bounds__(NWAVES * 64, 2) hybrid_fwd(Args args) {
    extern __shared__ __attribute__((aligned(16))) unsigned char lds[];
    Frame F;
    F.lds = (LAS unsigned char*)lds;
    F.MISC = (volatile LAS unsigned*)(F.lds + MISC_OFF);
    F.tid = threadIdx.x; F.lane = F.tid & 63; F.wave = __builtin_amdgcn_readfirstlane(F.tid >> 6);
    F.G = gridDim.x; { const int bx = blockIdx.x; F.vcu = (F.G % 8 == 0) ? (bx % 8) * (F.G / 8) + bx / 8 : bx; }
    unsigned char* ws = args.ws;
    F.ctl = (gu32*)(ws + WS_CTL);
    F.x = args.in[0]; F.meta = args.in[1]; F.norm_g = args.in[2]; F.w_in = args.in[3]; F.b_gate = args.in[4]; F.conv_a_w = args.in[5]; F.w_proj_a = args.in[6];
    F.conv_b_w = args.in[7]; F.conv_b_b = args.in[8]; F.w_rg_a = args.in[9]; F.b_rg_a = args.in[10]; F.w_rg_i = args.in[11]; F.b_rg_i = args.in[12]; F.lru = args.in[13];
    F.w_proj_b = args.in[14]; F.w_out = args.in[15]; F.fin_g = args.in[16];
    F.out = args.out; F.RS = (float*)(ws + WS_RS);
    F.WinT = (bf16_t*)(ws + WS_WIN); F.WabT = (bf16_t*)(ws + WS_WAB); F.WoutT = (bf16_t*)(ws + WS_WOUT); F.WgaT = (bf16_t*)(ws + WS_WGA); F.WgiT = (bf16_t*)(ws + WS_WGI);
    F.XN = (bf16_t*)(ws + WS_XN); F.XC = (bf16_t*)(ws + WS_XC); F.SA = (float*)(ws + WS_SA); F.SB = (float*)(ws + WS_SB); F.UV = (bf16_t*)(ws + WS_UV); F.GR = (bf16_t*)(ws + WS_GR); F.GB = (bf16_t*)(ws + WS_GB);
    for (int u = F.tid; u < (LDS_BYTES - LDSCTL_OFF) / 4; u += NWAVES * 64) ((LAS unsigned*)(F.lds + LDSCTL_OFF))[u] = 0u;
    __syncthreads();
    XcdBarrier bar; bar.bar = (unsigned*)(F.ctl + CW_BAR); bar.x = 0; bar.st = nullptr;
    if (N_LAUNCHES != PER_PHASE) bar = xcd_barrier_post((unsigned*)(F.ctl + CW_BAR), F.MISC + 8);
#define GRID_BAR() do { if (N_LAUNCHES != PER_PHASE) xcd_barrier(bar); } while (0)
    const int lo = args.ph_lo, hi = args.ph_hi;
#define IN(k) (lo <= (k) && (k) < hi)
#define BOTH(k) (IN(k) && IN((k) + 1))

#ifndef PROBE_REP
#define PROBE_REP -1
#endif
#define PH0() if (IN(0)) { p0_prologue(F); if (BOTH(0)) GRID_BAR(); }
#define PH1() if (IN(1)) { stagger_delay(STG1); \
        pg8::Gemm g{F.XN, F.WinT, 1024, 1024, 1024}; pg8::StaticOrder S; S.init(MP / 256, NIN / 256, F.G, (int)blockIdx.x); \
        EpiP1 E{F.UV, F.XC, F.GR, F.GB, F.SA, F.SB, F.b_gate, F.conv_a_w, F.conv_b_w, F.conv_b_b}; \
        pg8::gemm_phase<EpiP1, pg8::StaticOrder, true, true>(F.lds + RING_OFF, g, S, E); \
        if (BOTH(1)) GRID_BAR(); }
#define PH2()
#define PH3() if (IN(3)) { p2_scan(F); if (BOTH(3)) GRID_BAR(); }
#define PH4() if (IN(4)) { stagger_delay(STG4); \
        pg8::Gemm g{F.UV, F.WabT, 2048, 2048, 2048}; pg8::StaticOrder S; S.init(MR / 256, 4, F.G, (int)blockIdx.x); \
        EpiP3 E{F.GR, F.GB, F.XN}; \
        pg8::gemm_phase<EpiP3, pg8::StaticOrder, true, true>(F.lds + RING_OFF, g, S, E); \
        if (BOTH(4)) GRID_BAR(); }
#define PH5(RSP) if (IN(5)) { stagger_delay(STG5); \
        pg8::Gemm g{F.XN, F.WoutT, 1024, 1024, 1024}; pg8::StaticOrder S; S.init(MR / 256, 4, F.G, (int)blockIdx.x); \
        EpiP4 E{F.x, F.out, RSP}; \
        pg8::gemm_phase<EpiP4, pg8::StaticOrder, true, true>(F.lds + RING_OFF, g, S, E); \
        if (BOTH(5)) GRID_BAR(); }
    PH0()
#if PROBE_REP == 0
    PH0()
#endif
    PH1()
#if PROBE_REP == 1
    PH1()
#endif
    PH2()
    PH3()
#if PROBE_REP == 123
    PH1() PH2() PH3()
#endif
    PH4()
#if PROBE_REP == 4
    PH4()
#endif
#if PROBE_REP == 5
    PH5((float*)(args.ws + WS_SA))
#endif
    PH5(F.RS)
    if (IN(6)) { p5_final(F); }
#undef IN
#undef BOTH
#undef GRID_BAR
}

extern "C" void kernel_launch(void* const* d_in, const int* in_sizes, int n_in, void* d_out, int out_size, void* d_ws, size_t ws_size, hipStream_t stream) {
    static int grid = 0;
    if (grid == 0) {
        if (n_in != 17 || in_sizes[0] != MR * D || out_size != MR * D || ws_size < WS_END) {
            fprintf(stderr, "kernel_launch: unexpected shapes: n_in %d in0 %d out %d ws %zu (need %zu)\n", n_in, n_in > 0 ? in_sizes[0] : -1, out_size, ws_size, (size_t)WS_END); grid = -1; return; }
        int dev = 0, cus = 0, per_cu = 0;
        if (hipGetDevice(&dev) != hipSuccess || hipDeviceGetAttribute(&cus, hipDeviceAttributeMultiprocessorCount, dev) != hipSuccess) { fprintf(stderr, "kernel_launch: device query failed\n"); grid = -1; return; }
        if (hipFuncSetAttribute((const void*)hybrid_fwd, hipFuncAttributeMaxDynamicSharedMemorySize, LDS_BYTES) != hipSuccess) { fprintf(stderr, "kernel_launch: hipFuncSetAttribute failed\n"); grid = -1; return; }
        if (hipOccupancyMaxActiveBlocksPerMultiprocessor(&per_cu, (const void*)hybrid_fwd, NWAVES * 64, LDS_BYTES) != hipSuccess || per_cu < 1) {
            fprintf(stderr, "kernel_launch: occupancy query reports %d blocks per CU\n", per_cu); (void)hipGetLastError(); grid = -1; return; }
        (void)hipGetLastError();
        grid = cus;
    }
    if (grid < 0) return;
    if (hipMemsetAsync((char*)d_ws + WS_CTL, 0, CTL_ZERO_BYTES, stream) != hipSuccess) { fprintf(stderr, "kernel_launch: memset failed\n"); return; }
    Args a{};
    for (int i = 0; i < 17; ++i) a.in[i] = (const float*)d_in[i];
    a.out = (float*)d_out; a.ws = (unsigned char*)d_ws;
    for (int li = 0; li < N_LAUNCHES; ++li) {
        a.ph_lo = (N_LAUNCHES == PER_PHASE) ? li : 0; a.ph_hi = (N_LAUNCHES == PER_PHASE) ? li + 1 : PER_PHASE; a.li = li;
        hipLaunchKernelGGL(hybrid_fwd, dim3(grid), dim3(NWAVES * 64), LDS_BYTES, stream, a);
        const hipError_t le = hipPeekAtLastError();
        if (le != hipSuccess) { fprintf(stderr, "kernel_launch: launch %d failed: %s\n", li, hipGetErrorName(le)); break; }
    }
}
```
